# Optimizing an MI355X kernel written in HIP

```python
import math
import jax, jax.numpy as jnp
from jax import lax
import numpy as np

D_MODEL = 2048
BATCH = 1
SEQ = 8192
DEPTH = 1

D_MIX = D_MODEL
SSM_WIDTH = D_MIX // 2
CONV_WIDTH_CH = D_MIX - SSM_WIDTH
SSM_GROUP_CH = 16
SSM_GROUPS = SSM_WIDTH // SSM_GROUP_CH
SSM_STATE = 64
CONV_HEADS = 16
CONV_HEAD_DIM = CONV_WIDTH_CH // CONV_HEADS
CONV_K = 3
D_IN_PROJ = SSM_WIDTH + 3 * CONV_WIDTH_CH
D_FF = 5632
DT_MIN = 1e-3
DT_MAX = 1e-1
LN_EPS = 1e-5
RMS_EPS = 1e-6
ALPHA = (2.0 * DEPTH) ** 0.25
BETA = (8.0 * DEPTH) ** (-0.25)

kernel_name = "hymba_s5_shortconv_convffn_deepnorm"


def _layernorm(x, g, b):
    xf = x.astype(jnp.float32)
    mu = jnp.mean(xf, axis=-1, keepdims=True)
    xc = xf - mu
    var = jnp.mean(jnp.square(xc), axis=-1, keepdims=True)
    y = xc * lax.rsqrt(var + LN_EPS) * g.astype(jnp.float32) + b.astype(jnp.float32)
    return y.astype(x.dtype)


def _rmsnorm(x, g):
    xf = x.astype(jnp.float32)
    y = xf * lax.rsqrt(jnp.mean(jnp.square(xf), axis=-1, keepdims=True) + RMS_EPS)
    return (y * g.astype(jnp.float32)).astype(x.dtype)


def _causal_dwconv3(x, w):
    L = x.shape[1]
    xp = jnp.pad(x, ((0, 0), (CONV_K - 1, 0), (0, 0)))
    return xp[:, 0:L] * w[0] + xp[:, 1:L + 1] * w[1] + xp[:, 2:L + 2] * w[2]


def _s5_mixer(u, lam_re, lam_im, log_dt, b_re, b_im, c_re, c_im, d_skip, glu_w, glu_b):
    f32 = jnp.float32
    bsz, L, _ = u.shape
    ug = u.astype(f32).reshape(bsz, L, SSM_GROUPS, SSM_GROUP_CH)
    lam = lax.complex(lam_re.astype(f32), lam_im.astype(f32))
    dt = jnp.exp(log_dt.astype(f32))[:, None]
    lam_bar = jnp.exp(lam * dt)
    b = lax.complex(b_re.astype(f32), b_im.astype(f32))
    b_bar = ((lam_bar - 1.0) / lam)[..., None] * b
    bu = jnp.einsum('gph,blgh->blgp', b_bar, ug.astype(jnp.complex64))
    a = jnp.broadcast_to(lam_bar, bu.shape)

    def combine(left, right):
        a_l, b_l = left
        a_r, b_r = right
        return a_r * a_l, a_r * b_l + b_r

    _, states = lax.associative_scan(combine, (a, bu), axis=1)
    c = lax.complex(c_re.astype(f32), c_im.astype(f32))
    y = jnp.einsum('ghp,blgp->blgh', c, states).real \
        + d_skip.astype(f32).reshape(SSM_GROUPS, SSM_GROUP_CH) * ug
    y = y.reshape(bsz, L, SSM_WIDTH)
    g = jax.nn.gelu(y)
    out = g * jax.nn.sigmoid(g @ glu_w.astype(f32) + glu_b.astype(f32))
    return out.astype(u.dtype)


def _short_conv_mixer(gate_b, gate_c, v, conv_w):
    return gate_b * _causal_dwconv3(gate_c * v, conv_w)


def _conv_ffn(x, w_gate, w_up, conv_w, conv_b, w_down):
    a = _causal_dwconv3(x @ w_gate, conv_w) + conv_b
    return (jax.nn.silu(a) * (x @ w_up)) @ w_down


def setup_inputs(seed: int = 0) -> dict:
    key = jax.random.key(seed)
    ks = jax.random.split(key, 26)
    f32 = jnp.float32
    nrm = lambda k, shape, s: jax.random.normal(k, shape, f32) * s
    P, G, H = SSM_STATE, SSM_GROUPS, SSM_GROUP_CH

    x = jax.random.normal(ks[0], (BATCH, SEQ, D_MODEL), f32)
    w_in = nrm(ks[1], (DEPTH, D_MODEL, D_IN_PROJ), D_MODEL ** -0.5)
    ssm_lambda_re = -0.5 + nrm(ks[2], (DEPTH, G, P), 0.01)
    ssm_lambda_im = math.pi * jnp.arange(P, dtype=f32)[None, None, :] + nrm(ks[3], (DEPTH, G, P), 0.01)
    ssm_log_dt = jax.random.uniform(ks[4], (DEPTH, G), f32, minval=math.log(DT_MIN), maxval=math.log(DT_MAX))
    ssm_b_re = nrm(ks[5], (DEPTH, G, P, H), (2.0 * H) ** -0.5)
    ssm_b_im = nrm(ks[6], (DEPTH, G, P, H), (2.0 * H) ** -0.5)
    ssm_c_re = nrm(ks[7], (DEPTH, G, H, P), (2.0 * P) ** -0.5)
    ssm_c_im = nrm(ks[8], (DEPTH, G, H, P), (2.0 * P) ** -0.5)
    ssm_d = 1.0 + nrm(ks[9], (DEPTH, SSM_WIDTH), 0.1)
    ssm_glu_w = nrm(ks[10], (DEPTH, SSM_WIDTH, SSM_WIDTH), SSM_WIDTH ** -0.5)
    ssm_glu_b = nrm(ks[11], (DEPTH, SSM_WIDTH), 0.01)
    sconv_w = nrm(ks[12], (DEPTH, CONV_K, CONV_WIDTH_CH), CONV_K ** -0.5)
    norm_ssm_g = 1.0 + nrm(ks[13], (DEPTH, SSM_WIDTH), 0.02)
    norm_conv_g = 1.0 + nrm(ks[14], (DEPTH, CONV_WIDTH_CH), 0.02)
    w_out = nrm(ks[15], (DEPTH, D_MIX, D_MODEL), BETA * D_MIX ** -0.5)
    ln1_g = 1.0 + nrm(ks[16], (DEPTH, D_MODEL), 0.02)
    ln1_b = nrm(ks[17], (DEPTH, D_MODEL), 0.01)
    ffn_w_gate = nrm(ks[18], (DEPTH, D_MODEL, D_FF), D_MODEL ** -0.5)
    ffn_w_up = nrm(ks[19], (DEPTH, D_MODEL, D_FF), D_MODEL ** -0.5)
    ffn_conv_w = nrm(ks[20], (DEPTH, CONV_K, D_FF), CONV_K ** -0.5)
    ffn_conv_b = nrm(ks[21], (DEPTH, D_FF), 0.01)
    ffn_w_down = nrm(ks[22], (DEPTH, D_FF, D_MODEL), BETA * D_FF ** -0.5)
    ln2_g = 1.0 + nrm(ks[23], (DEPTH, D_MODEL), 0.02)
    ln2_b = nrm(ks[24], (DEPTH, D_MODEL), 0.01)
    return {
        "x": x, "w_in": w_in,
        "ssm_lambda_re": ssm_lambda_re, "ssm_lambda_im": ssm_lambda_im, "ssm_log_dt": ssm_log_dt,
        "ssm_b_re": ssm_b_re, "ssm_b_im": ssm_b_im, "ssm_c_re": ssm_c_re, "ssm_c_im": ssm_c_im,
        "ssm_d": ssm_d, "ssm_glu_w": ssm_glu_w, "ssm_glu_b": ssm_glu_b,
        "sconv_w": sconv_w, "norm_ssm_g": norm_ssm_g, "norm_conv_g": norm_conv_g,
        "w_out": w_out, "ln1_g": ln1_g, "ln1_b": ln1_b,
        "ffn_w_gate": ffn_w_gate, "ffn_w_up": ffn_w_up, "ffn_conv_w": ffn_conv_w,
        "ffn_conv_b": ffn_conv_b, "ffn_w_down": ffn_w_down, "ln2_g": ln2_g, "ln2_b": ln2_b,
    }


def reference(x, w_in, ssm_lambda_re, ssm_lambda_im, ssm_log_dt, ssm_b_re, ssm_b_im,
              ssm_c_re, ssm_c_im, ssm_d, ssm_glu_w, ssm_glu_b, sconv_w, norm_ssm_g,
              norm_conv_g, w_out, ln1_g, ln1_b, ffn_w_gate, ffn_w_up, ffn_conv_w,
              ffn_conv_b, ffn_w_down, ln2_g, ln2_b):
    h = x
    for l in range(DEPTH):
        proj = h @ w_in[l]
        u = proj[..., :SSM_WIDTH]
        gate_b, gate_c, v = jnp.split(proj[..., SSM_WIDTH:], 3, axis=-1)
        y_ssm = _s5_mixer(u, ssm_lambda_re[l], ssm_lambda_im[l], ssm_log_dt[l],
                          ssm_b_re[l], ssm_b_im[l], ssm_c_re[l], ssm_c_im[l],
                          ssm_d[l], ssm_glu_w[l], ssm_glu_b[l])
        y_conv = _short_conv_mixer(gate_b, gate_c, v, sconv_w[l])
        y_mix = jnp.concatenate([_rmsnorm(y_ssm, norm_ssm_g[l]),
                                 _rmsnorm(y_conv, norm_conv_g[l])], axis=-1)
        h = _layernorm(ALPHA * h + y_mix @ w_out[l], ln1_g[l], ln1_b[l])
        f = _conv_ffn(h, ffn_w_gate[l], ffn_w_up[l], ffn_conv_w[l], ffn_conv_b[l], ffn_w_down[l])
        h = _layernorm(ALPHA * h + f, ln2_g[l], ln2_b[l])
    return h
```

```cpp
#include <hip/hip_runtime.h>
#include <hip/hip_cooperative_groups.h>
#include <cstdio>
#include <cstdint>
namespace cg = cooperative_groups;

#ifndef PREISSUE
#define PREISSUE 0
#endif
#ifndef N_LAUNCH
#define N_LAUNCH 1
#endif

typedef unsigned short bf16_t;
using bf16x8 = __attribute__((ext_vector_type(8))) short;
using f32x4 = __attribute__((ext_vector_type(4))) float;
using u32x4 = __attribute__((ext_vector_type(4))) unsigned;
using u32x2 = __attribute__((ext_vector_type(2))) unsigned;

constexpr int L = 8192, D = 2048, DIN = 4096, SW = 1024, CW = 1024, NG = 64, GH = 16, NP = 64, DFF = 5632;
constexpr int TCH = 64, NCH = L / TCH;
constexpr float ALPHA = 1.189207115002721f;
constexpr float LN_EPS = 1e-5f, RMS_EPS = 1e-6f;

constexpr size_t MiB = 1024 * 1024;
constexpr size_t WS_WIN = 0, WS_WGLU = 16 * MiB, WS_WOUT = 18 * MiB, WS_WGU = 26 * MiB, WS_WD = 70 * MiB;
constexpr size_t WS_XB = 92 * MiB, WS_YMIX = 92 * MiB;
constexpr size_t WS_U = 124 * MiB, WS_H1B = 124 * MiB;
constexpr size_t WS_GBCV = 156 * MiB, WS_ACT = 156 * MiB;
constexpr size_t WS_G = 204 * MiB;
constexpr size_t WS_F = 244 * MiB, WS_LTP = 248 * MiB, WS_BBAR = 252 * MiB, WS_CT = 252 * MiB + 512 * 1024;
constexpr size_t WS_LAMB = 253 * MiB, WS_LAM64 = 253 * MiB + 64 * 1024, WS_CIN = 248 * MiB, WS_ROWSS = 253 * MiB + 256 * 1024, WS_ST1 = WS_ROWSS + 32 * 1024, WS_ST2 = WS_ST1 + 64 * 1024, WS_BAR = WS_ROWSS + 256 * 1024;

struct Params {
    const float *x, *w_in, *lam_re, *lam_im, *log_dt, *b_re, *b_im, *c_re, *c_im, *ssm_d, *glu_w, *glu_b, *sconv_w, *nsg, *ncg,
        *w_out, *ln1g, *ln1b, *wg, *wu, *fcw, *fcb, *wd, *ln2g, *ln2b;
    float* out;
    unsigned char* ws;
};

extern __shared__ __attribute__((aligned(16))) unsigned char smem[];

#define LAS __attribute__((address_space(3)))
#define XB_TMO      128
#define XB_XCNT(j)  (256  + 64 * (j))
#define XB_XSUB(j)  (1280 + 64 * (j))
#define XB_XGEN(j)  (2304 + 64 * (j))
#define XB_TOP      3328
#define XB_TOPGEN   3392
#define XCD_BAR_WORDS 3456
__device__ __forceinline__ int opaque_tid() { int t = threadIdx.x; asm volatile("" : "+v"(t)); return t; }
__device__ __forceinline__ unsigned pk2(float lo, float hi) { unsigned r; asm volatile("v_cvt_pk_bf16_f32 %0, %1, %2" : "=v"(r) : "v"(lo), "v"(hi)); return r; }
__device__ __forceinline__ float bflo(unsigned w) { return __uint_as_float(w << 16); }
__device__ __forceinline__ float bfhi(unsigned w) { return __uint_as_float(w & 0xffff0000u); }
__device__ __forceinline__ float sigmoidf_(float z) { return __builtin_amdgcn_rcpf(1.0f + __expf(-z)); }
__device__ __forceinline__ float gelu_tanh(float y) { float z = 0.7978845608028654f * (y + 0.044715f * y * y * y); return y * sigmoidf_(2.0f * z); }

__device__ __forceinline__ void dsincos(double th, double& s, double& c) {
    const double TWO_PI_HI = 6.283185307179586, TWO_PI_LO = 2.4492935982947064e-16;
    double n = rint(th * 0.15915494309189535);
    double r = fma(-n, TWO_PI_HI, th); r = fma(-n, TWO_PI_LO, r);
    double q = rint(r * 0.6366197723675814);
    double t = fma(-q, 1.5707963267948966, r); t = fma(-q, 6.123233995736766e-17, t);
    double t2 = t * t;
    double sp = t * (1.0 + t2 * (-1.0 / 6 + t2 * (1.0 / 120 + t2 * (-1.0 / 5040 + t2 * (1.0 / 362880 + t2 * (-1.0 / 39916800 + t2 * (1.0 / 6227020800.0)))))));
    double cp = 1.0 + t2 * (-0.5 + t2 * (1.0 / 24 + t2 * (-1.0 / 720 + t2 * (1.0 / 40320 + t2 * (-1.0 / 3628800 + t2 * (1.0 / 479001600.0 + t2 * (-1.0 / 87178291200.0)))))));
    int qi = ((int)q) & 3;
    s = (qi == 0) ? sp : (qi == 1) ? cp : (qi == 2) ? -sp : -cp;
    c = (qi == 0) ? cp : (qi == 1) ? -sp : (qi == 2) ? -cp : sp;
}
__device__ __forceinline__ double dexp(double x) {
    if (x < -700.0) return 0.0;
    double k = rint(x * 1.4426950408889634);
    double r = fma(-k, 0.6931471805599453, x); r = fma(-k, 2.3190468138462996e-17, r);
    double p = 1.0 + r * (1.0 + r * (0.5 + r * (1.0 / 6 + r * (1.0 / 24 + r * (1.0 / 120 + r * (1.0 / 720 + r * (1.0 / 5040 + r * (1.0 / 40320 + r * (1.0 / 362880 + r * (1.0 / 3628800 + r * (1.0 / 39916800 + r * (1.0 / 479001600.0))))))))))));
    long long bits = ((long long)((int)k + 1023)) << 52;
    return p * __longlong_as_double(bits);
}

struct Strip { const float* W; bf16_t* WT; int K, N, mode, k0, n0; };
constexpr int S_IN = (D / 64) * (DIN / 256), S_GLU = (SW / 64) * (SW / 256), S_OUT = (D / 64) * (D / 256), S_G = (D / 64) * (DFF / 256), S_D = (DFF / 64) * (D / 256);
constexpr int S_EARLY = S_IN + S_GLU + S_OUT + 2 * S_G;
constexpr int S_GU_EARLY = 0;
__device__ __forceinline__ Strip strip_desc(const Params& P, int sidx) {
    unsigned char* ws = P.ws;
    Strip t; int r = sidx;
    if (r < S_IN) { t.W = P.w_in; t.WT = (bf16_t*)(ws + WS_WIN); t.K = D; t.N = DIN; t.mode = 0; }
    else if ((r -= S_IN) < S_GLU) { t.W = P.glu_w; t.WT = (bf16_t*)(ws + WS_WGLU); t.K = SW; t.N = SW; t.mode = 0; }
    else if ((r -= S_GLU) < S_OUT) { t.W = P.w_out; t.WT = (bf16_t*)(ws + WS_WOUT); t.K = D; t.N = D; t.mode = 0; }
    else if ((r -= S_OUT) < S_G) { t.W = P.wg; t.WT = (bf16_t*)(ws + WS_WGU); t.K = D; t.N = DFF; t.mode = 1; }
    else if ((r -= S_G) < S_G) { t.W = P.wu; t.WT = (bf16_t*)(ws + WS_WGU); t.K = D; t.N = DFF; t.mode = 2; }
    else { r -= S_G; t.W = P.wd; t.WT = (bf16_t*)(ws + WS_WD); t.K = DFF; t.N = D; t.mode = 0; }
    const int nk = t.K / 64;
    t.k0 = (r % nk) * 64; t.n0 = (r / nk) * 256;
    return t;
}
__device__ __forceinline__ void strip_load(const Strip& t, int tid, f32x4 (&v)[8]) {
    const float* src = t.W + (size_t)(t.k0 + (tid >> 6)) * t.N + t.n0 + 4 * (tid & 63);
#pragma unroll
    for (int i = 0; i < 8; ++i) v[i] = *(const f32x4*)(src + (size_t)(8 * i) * t.N);
}
__device__ __forceinline__ void strip_lds_write(float* tile, int tid, const f32x4 (&v)[8]) {
#pragma unroll
    for (int i = 0; i < 8; ++i) *(f32x4*)(tile + ((tid >> 6) + 8 * i) * 256 + ((4 * (tid & 63)) ^ (i << 3))) = v[i];
}
__device__ __forceinline__ void strip_store(const float* tile, int tid, const Strip& cur) {
    const int kc = tid & 7;
#pragma unroll
    for (int j = 0; j < 4; ++j) {
        const int n = 64 * j + (tid >> 3);
        const float* q = tile + (8 * kc) * 256 + (n ^ (kc << 3));
        u32x4 o;
        o[0] = pk2(q[0 * 256], q[1 * 256]); o[1] = pk2(q[2 * 256], q[3 * 256]); o[2] = pk2(q[4 * 256], q[5 * 256]); o[3] = pk2(q[6 * 256], q[7 * 256]);
        const int nn = cur.n0 + n;
        int drow = nn;
        if (cur.mode == 1) drow = 256 * (nn >> 7) + (nn & 127);
        if (cur.mode == 2) drow = 256 * (nn >> 7) + 128 + (nn & 127);
        *(u32x4*)(cur.WT + (size_t)drow * cur.K + cur.k0 + 8 * kc) = o;
    }
}
__device__ __forceinline__ int strip_next(int cur, int step, unsigned* ctr, int first, int tid) {
    if (!ctr) return cur + step;
    LAS int* slot = (LAS int*)((LAS unsigned char*)smem + 2 * 65536 - 64);
    __syncthreads();
    if (tid == 0) *slot = first + (int)__hip_atomic_fetch_add(ctr, 1u, __ATOMIC_RELAXED, __HIP_MEMORY_SCOPE_AGENT);
    __syncthreads();
    return *slot;
}
__device__ __forceinline__ void convert_strips(const Params& P, int first, int last, int step, unsigned* ctr = nullptr) {
    float* tile = (float*)smem;
    const int tid = opaque_tid();
    f32x4 va[8], vb[8];
    int sa = ctr ? strip_next(0, 0, ctr, first, tid) : first;
    if (sa >= last) return;
    Strip da = strip_desc(P, sa);
    strip_load(da, tid, va);
    int sb = strip_next(sa, step, ctr, first, tid);
    Strip db = da;
    if (sb < last) { db = strip_desc(P, sb); strip_load(db, tid, vb); }
    for (;;) {
        strip_lds_write(tile, tid, va);
        __syncthreads();
        const Strip ca = da;
        sa = (sb < last) ? strip_next(sb, step, ctr, first, tid) : last;
        if (sa < last) { da = strip_desc(P, sa); strip_load(da, tid, va); }
        strip_store(tile, tid, ca);
        __syncthreads();
        if (sb >= last) break;
        strip_lds_write(tile, tid, vb);
        __syncthreads();
        const Strip cb = db;
        sb = (sa < last) ? strip_next(sa, step, ctr, first, tid) : last;
        if (sb < last) { db = strip_desc(P, sb); strip_load(db, tid, vb); }
        strip_store(tile, tid, cb);
        __syncthreads();
        if (sa >= last) break;
    }
}

__device__ __forceinline__ void phase0(const Params& P) {
    unsigned char* ws = P.ws;
    const int nb = gridDim.x, b = blockIdx.x, tid = opaque_tid();
    convert_strips(P, b, S_IN + S_GLU + S_OUT + S_GU_EARLY, nb);
    const size_t gt = (size_t)b * 512 + tid, ngt = (size_t)nb * 512;
    {
        u32x4* xb = (u32x4*)(ws + WS_XB);
        for (size_t e0 = gt; e0 < (size_t)L * D / 8; e0 += 4 * ngt) {
            f32x4 a[4], c[4];
#pragma unroll
            for (int q = 0; q < 4; ++q) { const size_t e = e0 + q * ngt; if (e < (size_t)L * D / 8) { a[q] = *(const f32x4*)(P.x + e * 8); c[q] = *(const f32x4*)(P.x + e * 8 + 4); } }
#pragma unroll
            for (int q = 0; q < 4; ++q) { const size_t e = e0 + q * ngt; if (e < (size_t)L * D / 8) {
                u32x4 o; o[0] = pk2(a[q][0], a[q][1]); o[1] = pk2(a[q][2], a[q][3]); o[2] = pk2(c[q][0], c[q][1]); o[3] = pk2(c[q][2], c[q][3]);
                xb[e] = o; } }
        }
    }
    {
        float* z = (float*)(ws + WS_ROWSS);
        for (size_t e = gt; e < (size_t)L * 5; e += ngt) z[e] = 0.f;
    }
    {
        float2* lamb = (float2*)(ws + WS_LAMB); float2* ltp = (float2*)(ws + WS_LAM64);
        u32x4* BT = (u32x4*)(ws + WS_BBAR); u32x4* CTT = (u32x4*)(ws + WS_CT);
        for (size_t e = gt; e < (size_t)NG * NP; e += ngt) {
            const int g = (int)(e >> 6);
            const double dt = dexp((double)P.log_dt[g]), lr = (double)P.lam_re[e], li = (double)P.lam_im[e];
            const double mag = dexp(lr * dt); double sn, cs; dsincos(li * dt, sn, cs);
            lamb[e] = make_float2((float)(mag * cs), (float)(mag * sn));
        }
        for (size_t e = gt; e < (size_t)NG * 4 * 64; e += ngt) {
            const int ln = (int)(e & 63), kb = (int)((e >> 6) & 3), g = (int)(e >> 8);
            const int pp = (ln & 31) + 32 * (kb >> 1), gp = g * 64 + pp, h0 = 8 * (ln >> 5);
            const double dt = dexp((double)P.log_dt[g]), lr = (double)P.lam_re[gp], li = (double)P.lam_im[gp];
            const double mag = dexp(lr * dt); double sn, cs; dsincos(li * dt, sn, cs);
            const double nr = mag * cs - 1.0, ni = mag * sn, den = lr * lr + li * li;
            const double cr = (nr * lr + ni * li) / den, ci = (ni * lr - nr * li) / den;
            float v[8];
#pragma unroll
            for (int q = 0; q < 8; ++q) {
                const double br = (double)P.b_re[(size_t)gp * GH + h0 + q], bi = (double)P.b_im[(size_t)gp * GH + h0 + q];
                v[q] = (kb & 1) ? (float)(cr * bi + ci * br) : (float)(cr * br - ci * bi);
            }
            u32x4 hi, lo;
#pragma unroll
            for (int q = 0; q < 4; ++q) { hi[q] = pk2(v[2 * q], v[2 * q + 1]); lo[q] = pk2(v[2 * q] - bflo(hi[q]), v[2 * q + 1] - bfhi(hi[q])); }
            BT[((size_t)(g * 4 + kb) * 2 + 0) * 64 + ln] = hi; BT[((size_t)(g * 4 + kb) * 2 + 1) * 64 + ln] = lo;
        }
        for (size_t e = gt; e < (size_t)NG * 8 * 64; e += ngt) {
            const int ln = (int)(e & 63), kk = (int)((e >> 6) & 7), g = (int)(e >> 9);
            const int ii = ln & 15, lopart = (ln >> 4) & 1, h = 8 * ((ii >> 2) & 1) + 4 * (ii >> 3) + (ii & 3);
            float v[8];
#pragma unroll
            for (int q = 0; q < 8; ++q) {
                const int kl = 16 * kk + 8 * (ln >> 5) + q, kb = kl >> 5, pp = (kl & 31) + 32 * (kb >> 1);
                const float cv = (kb & 1) ? -P.c_im[((size_t)g * GH + h) * NP + pp] : P.c_re[((size_t)g * GH + h) * NP + pp];
                v[q] = cv;
            }
            u32x4 o;
#pragma unroll
            for (int q = 0; q < 4; ++q) {
                const unsigned hi = pk2(v[2 * q], v[2 * q + 1]);
                o[q] = lopart ? pk2(v[2 * q] - bflo(hi), v[2 * q + 1] - bfhi(hi)) : hi;
            }
            CTT[e] = o;
        }
        for (size_t e = gt; e < (size_t)NG * NP; e += ngt) {
            const int gp = (int)e, g = gp >> 6;
            const double dt = dexp((double)P.log_dt[g]), lr = (double)P.lam_re[gp], li = (double)P.lam_im[gp];
            const double sc = dt * (double)TCH;
            const double mag = dexp(lr * sc); double sn, cs; dsincos(li * sc, sn, cs);
            ltp[e] = make_float2((float)(mag * cs), (float)(mag * sn));
        }
    }
}

constexpr int BM = 256, BK = 64, HALF = 128, HT = HALF * BK, NXCD = 8, WGM = 4;
__device__ __forceinline__ int lds_byte(int r, int c) { int st = (r >> 4) * 2 + (c >> 5), rr = r & 15, cc = c & 31, ob = rr * 64 + cc * 2; return st * 1024 + (ob ^ (((ob >> 9) & 1) << 5)); }
__device__ __forceinline__ void stage_rc(int b, int& R, int& C) { int st = b / 1024, sb = b % 1024, swz = sb ^ (((sb >> 9) & 1) << 5); R = (st >> 1) * 16 + swz / 64; C = (st & 1) * 32 + (swz % 64) / 2; }

enum { EPI_PROJ = 1, EPI_GLU = 2, EPI_OUT = 3, EPI_FFN = 4, EPI_DOWN = 5 };

__device__ __forceinline__ void xcd_barrier(unsigned char* wsb);

template <int K, int EPI, bool FUSE = false>
__device__ __forceinline__ void gemm_phase(const Params& P, const bf16_t* __restrict__ A, const bf16_t* __restrict__ Bt, int nM, int nN) {
    typedef __attribute__((address_space(3))) unsigned char lds_u8;
    lds_u8* lds = (lds_u8*)smem;
    unsigned char* ws = P.ws;
    constexpr int HTB = HT * 2;
#define SA(b, h) (((b) * 2 + (h)) * HTB)
#define SB(b, h) ((4 + (b) * 2 + (h)) * HTB)
#define STAGE_B(bufoff, br, kt) do { const char* _g = (const char*)Bt + ((size_t)(br) * K + (size_t)(kt) * BK) * 2; \
        __builtin_amdgcn_global_load_lds((const unsigned*)(_g + voffB0), (__attribute__((address_space(3))) unsigned*)(lds + (bufoff) + ldsw), 16, 0, 0); \
        __builtin_amdgcn_global_load_lds((const unsigned*)(_g + voffB1), (__attribute__((address_space(3))) unsigned*)(lds + (bufoff) + ldsw + 8192), 16, 0, 0); } while (0)
#define STAGE_A(bufoff, h, kt) do { if (EPI == EPI_FFN) { const char* _g = (const char*)A + (size_t)(kt) * BK * 2; \
        __builtin_amdgcn_global_load_lds((const unsigned*)(_g + aoff[h][0]), (__attribute__((address_space(3))) unsigned*)(lds + (bufoff) + ldsw), 16, 0, 0); \
        __builtin_amdgcn_global_load_lds((const unsigned*)(_g + aoff[h][1]), (__attribute__((address_space(3))) unsigned*)(lds + (bufoff) + ldsw + 8192), 16, 0, 0); \
      } else { const char* _g = (const char*)A + ((size_t)(brow + (h) * HALF) * K + (size_t)(kt) * BK) * 2; \
        __builtin_amdgcn_global_load_lds((const unsigned*)(_g + voffA0), (__attribute__((address_space(3))) unsigned*)(lds + (bufoff) + ldsw), 16, 0, 0); \
        __builtin_amdgcn_global_load_lds((const unsigned*)(_g + voffA1), (__attribute__((address_space(3))) unsigned*)(lds + (bufoff) + ldsw + 8192), 16, 0, 0); } } while (0)
#define STAGE_AX(bufoff, AO, h, kt) do { const char* _g = (const char*)A + (size_t)(kt) * BK * 2; \
        __builtin_amdgcn_global_load_lds((const unsigned*)(_g + AO[h][0]), (__attribute__((address_space(3))) unsigned*)(lds + (bufoff) + ldsw), 16, 0, 0); \
        __builtin_amdgcn_global_load_lds((const unsigned*)(_g + AO[h][1]), (__attribute__((address_space(3))) unsigned*)(lds + (bufoff) + ldsw + 8192), 16, 0, 0); } while (0)
#define LDA(dst, b, h) do { _Pragma("unroll") for (int m = 0; m < 4; ++m) _Pragma("unroll") for (int k = 0; k < 2; ++k) \
        dst[m][k] = *(const __attribute__((address_space(3))) bf16x8*)(lds + SA(b, h) + la_off + m * 2048 + k * 1024); } while (0)
#define LDB(dst, b, h) do { _Pragma("unroll") for (int n = 0; n < 2; ++n) _Pragma("unroll") for (int k = 0; k < 2; ++k) \
        dst[n][k] = *(const __attribute__((address_space(3))) bf16x8*)(lds + SB(b, h) + lb_off + n * 2048 + k * 1024); } while (0)
#define MMA(ai, bj, At_, Bt_) do { __builtin_amdgcn_s_setprio(1); \
        _Pragma("unroll") for (int m = 0; m < 4; ++m) _Pragma("unroll") for (int n = 0; n < 2; ++n) _Pragma("unroll") for (int k = 0; k < 2; ++k) \
            acc[ai][bj][m][n] = __builtin_amdgcn_mfma_f32_16x16x32_bf16(Bt_[n][k], At_[m][k], acc[ai][bj][m][n], 0, 0, 0); \
        __builtin_amdgcn_s_setprio(0); } while (0)
#define WAIT_V(n) asm volatile("s_waitcnt vmcnt(" #n ")" ::: "memory")
#define WAIT_L(n) asm volatile("s_waitcnt lgkmcnt(" #n ")" ::: "memory")
#define BAR __builtin_amdgcn_s_barrier()
#define SCHED __builtin_amdgcn_sched_barrier(0)

    const int tid = opaque_tid(), wid = tid >> 6, wr = wid >> 2;
    const int nwg = nM * nN, G = gridDim.x;
    constexpr int nt = K / BK;

    bool pre = false;
#define TILE_OF(Lw_, pm_, pn_) do { int wgid = (Lw_); \
        { const int q = nwg / NXCD, r = nwg % NXCD, xcd = wgid % NXCD, off = wgid / NXCD; wgid = (xcd < r ? xcd * (q + 1) : r * (q + 1) + (xcd - r) * q) + off; } \
        const int nig = WGM * nN, gid = wgid / nig, fm = gid * WGM, gsz = (nM - fm) < WGM ? (nM - fm) : WGM; \
        pm_ = fm + ((wgid % nig) % gsz); pn_ = (wgid % nig) / gsz; } while (0)
#define FFN_AOFF(AO, brow_) do { _Pragma("unroll") for (int h = 0; h < 2; ++h) { \
        int r0 = (brow_) + h * HALF + sR0, r1 = (brow_) + h * HALF + sR1; \
        r0 = r0 < 0 ? 0 : (r0 > L - 1 ? L - 1 : r0); r1 = r1 < 0 ? 0 : (r1 > L - 1 ? L - 1 : r1); \
        AO[h][0] = (unsigned)(r0 * K + sC0) * 2u; AO[h][1] = (unsigned)(r1 * K + sC1) * 2u; } } while (0)
    for (int it = 0;; ++it) {
        const int Lw = it * G + blockIdx.x;
        if (Lw >= nwg) break;
        const int tidk = opaque_tid(), lanek = tidk & 63, wck = (tidk >> 6) & 3, wrk = tidk >> 8, frk = lanek & 15, fqk = lanek >> 4;
        int sR0, sR1, sC0, sC1;
        stage_rc(tidk * 16, sR0, sC0); stage_rc(tidk * 16 + 8192, sR1, sC1);
        const int sRb0 = (EPI == EPI_FFN || EPI == EPI_PROJ || EPI == EPI_GLU || EPI == EPI_OUT) ? ((sR0 & ~31) + 8 * ((sR0 & 15) >> 2) + 4 * ((sR0 & 31) >> 4) + (sR0 & 3)) : sR0;
        const int sRb1 = (EPI == EPI_FFN || EPI == EPI_PROJ || EPI == EPI_GLU || EPI == EPI_OUT) ? ((sR1 & ~31) + 8 * ((sR1 & 15) >> 2) + 4 * ((sR1 & 31) >> 4) + (sR1 & 3)) : sR1;
        const unsigned voffB0 = (unsigned)(sRb0 * K + sC0) * 2u, voffB1 = (unsigned)(sRb1 * K + sC1) * 2u;
        const unsigned voffA0 = (unsigned)(sR0 * K + sC0) * 2u, voffA1 = (unsigned)(sR1 * K + sC1) * 2u;
        const unsigned ldsw = (unsigned)(tidk >> 6) * 1024u;
        const int la_off = lds_byte(wrk * 64 + frk, fqk * 8), lb_off = lds_byte(wck * 32 + frk, fqk * 8);
        int pm, pn;
        unsigned aoff[2][2];
        TILE_OF(Lw, pm, pn);
        if (EPI == EPI_FFN) FFN_AOFF(aoff, 254 * pm - 2);
        const int brow = (EPI == EPI_FFN) ? (254 * pm - 2) : pm * BM, bcol = pn * BM;
        f32x4 acc[2][2][4][2];
#pragma unroll
        for (int a = 0; a < 2; ++a)
#pragma unroll
            for (int b2 = 0; b2 < 2; ++b2)
#pragma unroll
                for (int m = 0; m < 4; ++m)
#pragma unroll
                    for (int n = 0; n < 2; ++n) acc[a][b2][m][n] = (f32x4){0.f, 0.f, 0.f, 0.f};
        bf16x8 At[4][2], B0[2][2], B1[2][2];

        if (EPI == EPI_FFN && pre) {
            if (wr == 1) BAR;
            WAIT_V(0); BAR;
        } else {
            STAGE_B(SB(0, 0), bcol, 0); STAGE_A(SA(0, 0), 0, 0);
            STAGE_B(SB(0, 1), bcol + HALF, 0); STAGE_A(SA(0, 1), 1, 0);
            if (wr == 1) BAR;
            WAIT_V(4); BAR;
        }
        STAGE_B(SB(1, 0), bcol, 1); STAGE_A(SA(1, 0), 0, 1); STAGE_B(SB(1, 1), bcol + HALF, 1);
        WAIT_V(6); BAR;
#pragma unroll 1
        for (int t = 0; t < nt - 2; t += 2) {
            if (EPI == EPI_OUT) {
                if (t == (SW / BK)) {
                    const float* rowss = (const float*)(ws + WS_ROWSS);
#pragma unroll
                    for (int ai = 0; ai < 2; ++ai)
#pragma unroll
                        for (int m = 0; m < 4; ++m) {
                            const int row = brow + ai * HALF + wrk * 64 + m * 16 + frk;
                            const float sc = rsqrtf(rowss[row] * (1.0f / SW) + RMS_EPS);
#pragma unroll
                            for (int bj = 0; bj < 2; ++bj)
#pragma unroll
                                for (int n = 0; n < 2; ++n) acc[ai][bj][m][n] *= sc;
                        }
                }
            }
            LDB(B0, 0, 0); SCHED; LDA(At, 0, 0); STAGE_A(SA(1, 1), 1, t + 1);
            WAIT_L(8); BAR; WAIT_L(0); MMA(0, 0, At, B0); BAR; SCHED;
            LDB(B1, 0, 1); STAGE_B(SB(0, 0), bcol, t + 2);
            BAR; WAIT_L(0); MMA(0, 1, At, B1); BAR;
            LDA(At, 0, 1); STAGE_A(SA(0, 0), 0, t + 2);
            BAR; WAIT_L(0); MMA(1, 0, At, B0); BAR; SCHED;
            STAGE_B(SB(0, 1), bcol + HALF, t + 2);
            WAIT_V(6); BAR; MMA(1, 1, At, B1); BAR;
            LDB(B0, 1, 0); SCHED; LDA(At, 1, 0); STAGE_A(SA(0, 1), 1, t + 2);
            WAIT_L(8); BAR; WAIT_L(0); MMA(0, 0, At, B0); BAR; SCHED;
            LDB(B1, 1, 1); STAGE_B(SB(1, 0), bcol, t + 3);
            BAR; WAIT_L(0); MMA(0, 1, At, B1); BAR;
            LDA(At, 1, 1); STAGE_A(SA(1, 0), 0, t + 3);
            BAR; WAIT_L(0); MMA(1, 0, At, B0); BAR; SCHED;
            STAGE_B(SB(1, 1), bcol + HALF, t + 3);
            WAIT_V(6); BAR; MMA(1, 1, At, B1); BAR;
        }
        { LDB(B0, 0, 0); LDA(At, 0, 0); STAGE_A(SA(1, 1), 1, nt - 1);
          BAR; WAIT_L(0); MMA(0, 0, At, B0); BAR;
          LDB(B1, 0, 1); BAR; WAIT_L(0); MMA(0, 1, At, B1); BAR;
          LDA(At, 0, 1); WAIT_V(4); BAR; WAIT_L(0); MMA(1, 0, At, B0); MMA(1, 1, At, B1); BAR; }
        { LDB(B0, 1, 0); LDA(At, 1, 0); WAIT_V(2); BAR; WAIT_L(0); MMA(0, 0, At, B0); BAR;
          LDB(B1, 1, 1); WAIT_V(0); BAR; WAIT_L(0); MMA(0, 1, At, B1); BAR;
          LDA(At, 1, 1); BAR; WAIT_L(0); MMA(1, 0, At, B0); MMA(1, 1, At, B1); BAR; }
        if (wr == 0) BAR;

        const int tide = opaque_tid(), lane = tide & 63, wc = (tide >> 6) & 3, wre = tide >> 8, fr = lane & 15, fq = lane >> 4;
        const int row0 = brow + wre * 64 + fr, col0 = bcol + wc * 32 + 4 * fq;
        if (EPI == EPI_PROJ) {
            const int col0p = bcol + wc * 32 + 8 * fq;
            if (bcol < SW) {
                float* U = (float*)(ws + WS_U);
#pragma unroll
                for (int ai = 0; ai < 2; ++ai)
#pragma unroll
                    for (int m = 0; m < 4; ++m)
#pragma unroll
                        for (int bj = 0; bj < 2; ++bj)
#pragma unroll
                            for (int n = 0; n < 2; ++n)
                                *(f32x4*)(U + (size_t)(row0 + ai * HALF + m * 16) * SW + col0p + bj * HALF + 4 * n) = acc[ai][bj][m][n];
            } else {
                bf16_t* Gb = (bf16_t*)(ws + WS_GBCV);
#pragma unroll
                for (int ai = 0; ai < 2; ++ai)
#pragma unroll
                    for (int m = 0; m < 4; ++m)
#pragma unroll
                        for (int bj = 0; bj < 2; ++bj) {
                            const f32x4 v0 = acc[ai][bj][m][0], v1 = acc[ai][bj][m][1];
                            u32x4 o; o[0] = pk2(v0[0], v0[1]); o[1] = pk2(v0[2], v0[3]); o[2] = pk2(v1[0], v1[1]); o[3] = pk2(v1[2], v1[3]);
                            *(u32x4*)(Gb + (size_t)(row0 + ai * HALF + m * 16) * (3 * CW) + (col0p - SW) + bj * HALF) = o;
                        }
            }
        }
        if (EPI == EPI_GLU) {
            const int col0p = bcol + wc * 32 + 8 * fq;
            const bf16_t* Gg = (const bf16_t*)(ws + WS_G);
            bf16_t* Y = (bf16_t*)(ws + WS_YMIX);
            float* rowss = (float*)(ws + WS_ROWSS);
#pragma unroll
            for (int ai = 0; ai < 2; ++ai)
#pragma unroll
                for (int m = 0; m < 4; ++m) {
                    const int row = row0 + ai * HALF + m * 16;
                    float ss = 0.f;
#pragma unroll
                    for (int bj = 0; bj < 2; ++bj) {
                        const int col = col0p + bj * HALF;
                        const u32x4 gw = *(const u32x4*)(Gg + (size_t)row * SW + col);
                        u32x4 w;
#pragma unroll
                        for (int n = 0; n < 2; ++n) {
                            const f32x4 bz = *(const f32x4*)(P.glu_b + col + 4 * n), gn = *(const f32x4*)(P.nsg + col + 4 * n);
                            const f32x4 gv = (f32x4){bflo(gw[2 * n]), bfhi(gw[2 * n]), bflo(gw[2 * n + 1]), bfhi(gw[2 * n + 1])};
                            f32x4 o;
#pragma unroll
                            for (int j = 0; j < 4; ++j) { o[j] = gv[j] * sigmoidf_(acc[ai][bj][m][n][j] + bz[j]); ss += o[j] * o[j]; o[j] *= gn[j]; }
                            w[2 * n] = pk2(o[0], o[1]); w[2 * n + 1] = pk2(o[2], o[3]);
                        }
                        *(u32x4*)(Y + (size_t)row * D + col) = w;
                    }
                    ss += __shfl_xor(ss, 16); ss += __shfl_xor(ss, 32);
                    if (fq == 0) atomicAdd(rowss + row, ss);
                }
        }
        if (EPI == EPI_OUT || EPI == EPI_DOWN) {
            const float* R = (EPI == EPI_OUT) ? P.x : P.out;
            float* st = (float*)(ws + ((EPI == EPI_OUT) ? WS_ST1 : WS_ST2));
#pragma unroll
            for (int ai = 0; ai < 2; ++ai)
#pragma unroll
                for (int m = 0; m < 4; ++m) {
                    const int row = row0 + ai * HALF + m * 16;
                    float s1 = 0.f, s2 = 0.f;
#pragma unroll
                    for (int bj = 0; bj < 2; ++bj)
#pragma unroll
                        for (int n = 0; n < 2; ++n) {
                            const int col = (EPI == EPI_OUT) ? (bcol + wc * 32 + 8 * fq + bj * HALF + 4 * n) : (col0 + bj * HALF + n * 16);
                            const f32x4 rv = *(const f32x4*)(R + (size_t)row * D + col);
                            f32x4 o;
#pragma unroll
                            for (int j = 0; j < 4; ++j) { o[j] = ALPHA * rv[j] + acc[ai][bj][m][n][j]; s1 += o[j]; s2 += o[j] * o[j]; }
                            if (FUSE) acc[ai][bj][m][n] = o; else *(f32x4*)(P.out + (size_t)row * D + col) = o;
                        }
                    s1 += __shfl_xor(s1, 16); s1 += __shfl_xor(s1, 32);
                    s2 += __shfl_xor(s2, 16); s2 += __shfl_xor(s2, 32);
                    if (fq == 0) { atomicAdd(st + 2 * row, s1); atomicAdd(st + 2 * row + 1, s2); }
                }
            if (FUSE) {
                xcd_barrier(P.ws);
                const int tf = opaque_tid(), lf = tf & 63, r0f = brow + (tf >> 8) * 64 + (lf & 15), c0f = bcol + ((tf >> 6) & 3) * 32 + ((EPI == EPI_OUT) ? 8 : 4) * (lf >> 4);
                const float* gam = (EPI == EPI_OUT) ? P.ln1g : P.ln2g; const float* bet = (EPI == EPI_OUT) ? P.ln1b : P.ln2b;
                bf16_t* HB = (bf16_t*)(ws + WS_H1B);
#pragma unroll
                for (int ai = 0; ai < 2; ++ai)
#pragma unroll
                    for (int m = 0; m < 4; ++m) {
                        const int row = r0f + ai * HALF + m * 16;
                        const float s1 = __hip_atomic_load(st + 2 * row, __ATOMIC_RELAXED, __HIP_MEMORY_SCOPE_AGENT), s2 = __hip_atomic_load(st + 2 * row + 1, __ATOMIC_RELAXED, __HIP_MEMORY_SCOPE_AGENT);
                        const float mean = s1 * (1.0f / D);
                        const float rstd = rsqrtf(fmaxf(s2 * (1.0f / D) - mean * mean, 0.f) + LN_EPS);
#pragma unroll
                        for (int bj = 0; bj < 2; ++bj) {
                            u32x4 wb;
#pragma unroll
                            for (int n = 0; n < 2; ++n) {
                                const int col = c0f + bj * HALF + n * ((EPI == EPI_OUT) ? 4 : 16);
                                const f32x4 gv = *(const f32x4*)(gam + col), bv = *(const f32x4*)(bet + col);
                                f32x4 o;
#pragma unroll
                                for (int j = 0; j < 4; ++j) o[j] = (acc[ai][bj][m][n][j] - mean) * rstd * gv[j] + bv[j];
                                *(f32x4*)(P.out + (size_t)row * D + col) = o;
                                wb[2 * n] = pk2(o[0], o[1]); wb[2 * n + 1] = pk2(o[2], o[3]);
                            }
                            if (EPI == EPI_OUT) *(u32x4*)(HB + (size_t)row * D + c0f + bj * HALF) = wb;
                        }
                    }
            }
        }
        if (EPI == EPI_FFN) {
            f32x4 w0[2], w1[2], w2[2], cb[2];
            const int c0 = pn * 128 + wc * 32 + 8 * fq;
#pragma unroll
            for (int n = 0; n < 2; ++n) {
                const int c = c0 + 4 * n;
                w0[n] = *(const f32x4*)(P.fcw + c); w1[n] = *(const f32x4*)(P.fcw + DFF + c); w2[n] = *(const f32x4*)(P.fcw + 2 * DFF + c); cb[n] = *(const f32x4*)(P.fcb + c);
            }
            pre = false;
            LAS unsigned char* Gs = (LAS unsigned char*)smem + 65536;
            const int ch = 4 * wc + fq;
#pragma unroll
            for (int ai = 0; ai < 2; ++ai)
#pragma unroll
                for (int m = 0; m < 4; ++m) {
                    const int rl = ai * HALF + wre * 64 + m * 16 + fr;
                    f32x4 v0 = acc[ai][0][m][0], v1 = acc[ai][0][m][1];
                    if (brow + rl < 0) { v0 = (f32x4){0.f, 0.f, 0.f, 0.f}; v1 = v0; }
                    u32x4 w; w[0] = pk2(v0[0], v0[1]); w[1] = pk2(v0[2], v0[3]); w[2] = pk2(v1[0], v1[1]); w[3] = pk2(v1[2], v1[3]);
                    *(LAS u32x4*)(Gs + rl * 256 + ((ch ^ (rl & 15)) << 4)) = w;
                }
            __syncthreads();
            bf16_t* ACT = (bf16_t*)(ws + WS_ACT);
#pragma unroll
            for (int ai = 0; ai < 2; ++ai)
#pragma unroll
                for (int m = 0; m < 4; ++m) {
                    const int rl = ai * HALF + wre * 64 + m * 16 + fr, grow = brow + rl;
                    const int r1 = rl >= 1 ? rl - 1 : 0, r2 = rl >= 2 ? rl - 2 : 0;
                    {
                        const u32x4 a1 = *(const LAS u32x4*)(Gs + r1 * 256 + ((ch ^ (r1 & 15)) << 4));
                        const u32x4 a2 = *(const LAS u32x4*)(Gs + r2 * 256 + ((ch ^ (r2 & 15)) << 4));
                        u32x4 w;
#pragma unroll
                        for (int n = 0; n < 2; ++n) {
                            const f32x4 g1 = (f32x4){bflo(a1[2 * n]), bfhi(a1[2 * n]), bflo(a1[2 * n + 1]), bfhi(a1[2 * n + 1])};
                            const f32x4 g2 = (f32x4){bflo(a2[2 * n]), bfhi(a2[2 * n]), bflo(a2[2 * n + 1]), bfhi(a2[2 * n + 1])};
                            const f32x4 g0 = acc[ai][0][m][n], up = acc[ai][1][m][n];
                            f32x4 o;
                            { const f32x4 a4 = w0[n] * g2 + w1[n] * g1 + w2[n] * g0 + cb[n];
                              const f32x4 t4 = a4 * (-1.4426950408889634f);
                              f32x4 e4; e4[0] = __builtin_amdgcn_exp2f(t4[0]); e4[1] = __builtin_amdgcn_exp2f(t4[1]); e4[2] = __builtin_amdgcn_exp2f(t4[2]); e4[3] = __builtin_amdgcn_exp2f(t4[3]);
                              const f32x4 d4 = e4 + 1.0f;
                              f32x4 r4; r4[0] = __builtin_amdgcn_rcpf(d4[0]); r4[1] = __builtin_amdgcn_rcpf(d4[1]); r4[2] = __builtin_amdgcn_rcpf(d4[2]); r4[3] = __builtin_amdgcn_rcpf(d4[3]);
                              o = a4 * r4 * up; }
                            w[2 * n] = pk2(o[0], o[1]); w[2 * n + 1] = pk2(o[2], o[3]);
                        }
                        if (rl >= 2 && grow < L) *(u32x4*)(ACT + (size_t)grow * DFF + c0) = w;
                    }
                }
            __syncthreads();
        }
    }
#undef TILE_OF
#undef FFN_AOFF
#undef STAGE_AX
#undef SA
#undef SB
#undef STAGE_A
#undef STAGE_B
#undef LDA
#undef LDB
#undef MMA
}

using f32x16 = __attribute__((ext_vector_type(16))) float;
typedef short s16x4 __attribute__((ext_vector_type(4)));
#define MFMA32(a, b, c) __builtin_amdgcn_mfma_f32_32x32x16_bf16((a), (b), (c), 0, 0, 0)
__device__ __forceinline__ bf16x8 as_bf16x8(u32x4 v) { return __builtin_bit_cast(bf16x8, v); }
#define CMUL_R(ar, ai, br, bi) ((ar) * (br) - (ai) * (bi))
#define CMUL_I(ar, ai, br, bi) ((ar) * (bi) + (ai) * (br))

template <bool PASSB, bool LOCAL = false>
__device__ __forceinline__ void ssm_phase(const Params& P) {
    unsigned char* ws = P.ws;
    const int tid = opaque_tid(), wid = tid >> 6, lane = tid & 63, pj = lane & 31, hf = lane >> 5;
    LAS unsigned char* xt = (LAS unsigned char*)smem + wid * 9216;
    LAS u32x4* bts = (LAS u32x4*)((LAS unsigned char*)smem + 8 * 9216 + 8192);
    LAS u32x4* cts = (LAS u32x4*)((LAS unsigned char*)smem + 8 * 9216);
    const float* U = (const float*)(ws + WS_U);
    const float2* lamb = (const float2*)(ws + WS_LAMB); const float2* Cin = (const float2*)(ws + WS_CIN); float2* F = (float2*)(ws + WS_F);
    const u32x4* BT = (const u32x4*)(ws + WS_BBAR); const u32x4* CTT = (const u32x4*)(ws + WS_CT);
    bf16_t* Gout = (bf16_t*)(ws + WS_G);
    typedef float f32x2v __attribute__((ext_vector_type(2)));
    LAS f32x2v* Fl = (LAS f32x2v*)((LAS unsigned char*)smem + 8 * 9216 + 16384);
    float2* QT = (float2*)(ws + WS_CIN);
    const float2* l64g = (const float2*)(ws + WS_LAM64);
    for (int it = blockIdx.x; it < NG * 4; it += gridDim.x) {
      const int g = it & 63, cq = it >> 6;
      __syncthreads();
      bts[tid] = BT[(size_t)g * 512 + tid];
      if (PASSB) cts[tid] = CTT[(size_t)g * 512 + tid];
      if (PASSB && LOCAL && wid == 0) {
          const float2 lm = l64g[g * 64 + lane];
          float pr = lm.x, pi_ = lm.y;
#pragma unroll
          for (int k = 0; k < 5; ++k) { const float nr = CMUL_R(pr, pi_, pr, pi_), ni = CMUL_I(pr, pi_, pr, pi_); pr = nr; pi_ = ni; }
          float sr = 0.f, si = 0.f;
          for (int q = 0; q < cq; ++q) { const float2 tq = QT[((size_t)g * 4 + q) * 64 + lane]; const float nr = CMUL_R(pr, pi_, sr, si) + tq.x, ni = CMUL_I(pr, pi_, sr, si) + tq.y; sr = nr; si = ni; }
          float wr_ = sr, wi_ = si;
          for (int ci2 = 0; ci2 < 32; ++ci2) {
              const f32x2v pf = Fl[ci2 * 64 + lane];
              Fl[ci2 * 64 + lane] = (f32x2v){pf.x + wr_, pf.y + wi_};
              const float nr = CMUL_R(lm.x, lm.y, wr_, wi_), ni = CMUL_I(lm.x, lm.y, wr_, wi_); wr_ = nr; wi_ = ni;
          }
      }
      __syncthreads();
      const float2 lA = lamb[g * 64 + pj], lB = lamb[g * 64 + pj + 32];
      float l1[2][2] = {{lA.x, lA.y}, {lB.x, lB.y}}, l2[2][2], l3[2][2], l4[2][2];
#pragma unroll
      for (int sbi = 0; sbi < 2; ++sbi) {
          l2[sbi][0] = CMUL_R(l1[sbi][0], l1[sbi][1], l1[sbi][0], l1[sbi][1]); l2[sbi][1] = CMUL_I(l1[sbi][0], l1[sbi][1], l1[sbi][0], l1[sbi][1]);
          l3[sbi][0] = CMUL_R(l2[sbi][0], l2[sbi][1], l1[sbi][0], l1[sbi][1]); l3[sbi][1] = CMUL_I(l2[sbi][0], l2[sbi][1], l1[sbi][0], l1[sbi][1]);
          l4[sbi][0] = CMUL_R(l2[sbi][0], l2[sbi][1], l2[sbi][0], l2[sbi][1]); l4[sbi][1] = CMUL_I(l2[sbi][0], l2[sbi][1], l2[sbi][0], l2[sbi][1]);
      }
      const int i16 = lane & 15;
      const int traddr = (8 * hf + (i16 >> 2)) * 72 + (16 * ((lane >> 4) & 1) + 4 * (i16 & 3)) * 2;
      if (!PASSB) {
          float l5[2][2], l32[2][2];
#pragma unroll
          for (int sbi = 0; sbi < 2; ++sbi) {
              l5[sbi][0] = CMUL_R(l4[sbi][0], l4[sbi][1], l1[sbi][0], l1[sbi][1]); l5[sbi][1] = CMUL_I(l4[sbi][0], l4[sbi][1], l1[sbi][0], l1[sbi][1]);
              float ar = l4[sbi][0], ai = l4[sbi][1];
#pragma unroll
              for (int k = 0; k < 3; ++k) { const float nr = CMUL_R(ar, ai, ar, ai), ni = CMUL_I(ar, ai, ar, ai); ar = nr; ai = ni; }
              l32[sbi][0] = ar; l32[sbi][1] = ai;
          }
#pragma unroll 1
          for (int kp = 0; kp < 4; kp += 2) {
              float cr2[2][2] = {{0.f, 0.f}, {0.f, 0.f}}, ci2[2][2] = {{0.f, 0.f}, {0.f, 0.f}};
#pragma unroll 1
              for (int tb = 0; tb < 2; ++tb) {
                  f32x16 z2[2][4];
#pragma unroll
                  for (int j = 0; j < 2; ++j) {
                      const int t0 = (cq * 32 + wid + 8 * (kp + j)) * TCH;
                      const float* up = U + (size_t)(t0 + 32 * tb + pj) * SW + g * GH + 8 * hf;
                      const f32x4 u0 = *(const f32x4*)up, u1 = *(const f32x4*)(up + 4);
                      u32x4 hi, lo;
#pragma unroll
                      for (int q = 0; q < 4; ++q) {
                          const float a = (q < 2 ? u0 : u1)[2 * (q & 1)], b = (q < 2 ? u0 : u1)[2 * (q & 1) + 1];
                          hi[q] = pk2(a, b); lo[q] = pk2(a - bflo(hi[q]), b - bfhi(hi[q]));
                      }
                      const bf16x8 uh = as_bf16x8(hi), ul = as_bf16x8(lo);
#pragma unroll
                      for (int kb = 0; kb < 4; ++kb) {
                          const bf16x8 bhk = as_bf16x8(bts[(kb * 2 + 0) * 64 + lane]), blk = as_bf16x8(bts[(kb * 2 + 1) * 64 + lane]);
                          f32x16 acc;
#pragma unroll
                          for (int r = 0; r < 16; ++r) acc[r] = 0.f;
                          acc = MFMA32(uh, bhk, acc); acc = MFMA32(ul, bhk, acc); acc = MFMA32(uh, blk, acc);
                          z2[j][kb] = acc;
                      }
                  }
#pragma unroll
                  for (int j = 0; j < 2; ++j)
#pragma unroll
                      for (int sbi = 0; sbi < 2; ++sbi) {
                          float hr = z2[j][2 * sbi][0], hi_ = z2[j][2 * sbi + 1][0];
#pragma unroll
                          for (int r = 1; r < 16; ++r) {
                              const float fr_ = (r & 3) ? l1[sbi][0] : l5[sbi][0], fi_ = (r & 3) ? l1[sbi][1] : l5[sbi][1];
                              const float nr = CMUL_R(fr_, fi_, hr, hi_) + z2[j][2 * sbi][r], ni = CMUL_I(fr_, fi_, hr, hi_) + z2[j][2 * sbi + 1][r];
                              hr = nr; hi_ = ni;
                          }
                          const float or_ = __shfl_xor(hr, 32), oi_ = __shfl_xor(hi_, 32);
                          const float h0r = hf ? or_ : hr, h0i = hf ? oi_ : hi_, h1r = hf ? hr : or_, h1i = hf ? hi_ : oi_;
                          const float er = CMUL_R(l4[sbi][0], l4[sbi][1], h0r, h0i) + h1r, ei = CMUL_I(l4[sbi][0], l4[sbi][1], h0r, h0i) + h1i;
                          const float c0r = cr2[j][sbi], c0i = ci2[j][sbi];
                          cr2[j][sbi] = CMUL_R(l32[sbi][0], l32[sbi][1], c0r, c0i) + er; ci2[j][sbi] = CMUL_I(l32[sbi][0], l32[sbi][1], c0r, c0i) + ei;
                      }
              }
#pragma unroll
              for (int j = 0; j < 2; ++j) {
                  const int k4j = kp + j, cj = cq * 32 + wid + 8 * k4j;
                  const float2 fv = make_float2(hf ? cr2[j][1] : cr2[j][0], hf ? ci2[j][1] : ci2[j][0]);
                  if (LOCAL) Fl[(wid + 8 * k4j) * 64 + lane] = (f32x2v){fv.x, fv.y}; else F[(size_t)cj * 4096 + g * 64 + lane] = fv;
              }
          }
      } else
      for (int k4 = 0; k4 < 4; ++k4) {
        const int c = cq * 32 + wid + 8 * k4, t0 = c * TCH;
        float cr[2] = {0.f, 0.f}, ci[2] = {0.f, 0.f};
        if (PASSB) {
            float2 cv;
            if (LOCAL) { const f32x2v t2 = Fl[(wid + 8 * k4) * 64 + lane]; cv = make_float2(t2.x, t2.y); } else cv = Cin[(size_t)c * 4096 + g * 64 + lane];
            cr[0] = __shfl(cv.x, pj); ci[0] = __shfl(cv.y, pj); cr[1] = __shfl(cv.x, pj + 32); ci[1] = __shfl(cv.y, pj + 32);
        }
#pragma unroll 1
        for (int tb = 0; tb < 2; ++tb) {
            f32x4 u[2]; bf16x8 uh, ul;
            {
                const float* up = U + (size_t)(t0 + 32 * tb + pj) * SW + g * GH + 8 * hf;
                u[0] = *(const f32x4*)up; u[1] = *(const f32x4*)(up + 4);
                u32x4 hi, lo;
#pragma unroll
                for (int q = 0; q < 4; ++q) {
                    const float a = u[q >> 1][2 * (q & 1)], b = u[q >> 1][2 * (q & 1) + 1];
                    hi[q] = pk2(a, b); lo[q] = pk2(a - bflo(hi[q]), b - bfhi(hi[q]));
                }
                uh = as_bf16x8(hi); ul = as_bf16x8(lo);
            }
            f32x16 z[4];
#pragma unroll
            for (int kb = 0; kb < 4; ++kb) {
                const bf16x8 bhk = as_bf16x8(bts[(kb * 2 + 0) * 64 + lane]), blk = as_bf16x8(bts[(kb * 2 + 1) * 64 + lane]);
                f32x16 acc;
#pragma unroll
                for (int r = 0; r < 16; ++r) acc[r] = 0.f;
                acc = MFMA32(uh, bhk, acc); acc = MFMA32(ul, bhk, acc); acc = MFMA32(uh, blk, acc);
                z[kb] = acc;
            }
#pragma unroll
            for (int sbi = 0; sbi < 2; ++sbi)
#pragma unroll
                for (int q = 0; q < 4; ++q)
#pragma unroll
                    for (int sx = 1; sx < 4; ++sx) {
                        const int r = 4 * q + sx;
                        const float xr = z[2 * sbi][r - 1], xi = z[2 * sbi + 1][r - 1];
                        z[2 * sbi][r] += CMUL_R(l1[sbi][0], l1[sbi][1], xr, xi);
                        z[2 * sbi + 1][r] += CMUL_I(l1[sbi][0], l1[sbi][1], xr, xi);
                    }
#pragma unroll
            for (int q = 0; q < 4; ++q)
#pragma unroll
                for (int sbi = 0; sbi < 2; ++sbi) {
                    const float owr = z[2 * sbi][4 * q + 3], owi = z[2 * sbi + 1][4 * q + 3];
                    const float otr = __shfl_xor(owr, 32), oti = __shfl_xor(owi, 32);
                    const float ear = hf ? otr : owr, eai = hf ? oti : owi, ebr = hf ? owr : otr, ebi = hf ? owi : oti;
                    const float c0r = cr[sbi], c0i = ci[sbi];
                    const float c1r = CMUL_R(l4[sbi][0], l4[sbi][1], c0r, c0i) + ear, c1i = CMUL_I(l4[sbi][0], l4[sbi][1], c0r, c0i) + eai;
                    const float c2r = CMUL_R(l4[sbi][0], l4[sbi][1], c1r, c1i) + ebr, c2i = CMUL_I(l4[sbi][0], l4[sbi][1], c1r, c1i) + ebi;
                    if (PASSB) {
                        const float mr = hf ? c1r : c0r, mi = hf ? c1i : c0i;
                        z[2 * sbi][4 * q + 0] += CMUL_R(l1[sbi][0], l1[sbi][1], mr, mi); z[2 * sbi + 1][4 * q + 0] += CMUL_I(l1[sbi][0], l1[sbi][1], mr, mi);
                        z[2 * sbi][4 * q + 1] += CMUL_R(l2[sbi][0], l2[sbi][1], mr, mi); z[2 * sbi + 1][4 * q + 1] += CMUL_I(l2[sbi][0], l2[sbi][1], mr, mi);
                        z[2 * sbi][4 * q + 2] += CMUL_R(l3[sbi][0], l3[sbi][1], mr, mi); z[2 * sbi + 1][4 * q + 2] += CMUL_I(l3[sbi][0], l3[sbi][1], mr, mi);
                        z[2 * sbi][4 * q + 3] += CMUL_R(l4[sbi][0], l4[sbi][1], mr, mi); z[2 * sbi + 1][4 * q + 3] += CMUL_I(l4[sbi][0], l4[sbi][1], mr, mi);
                    }
                    cr[sbi] = c2r; ci[sbi] = c2i;
                }
            if (PASSB) {
#pragma unroll
                for (int kb = 0; kb < 4; ++kb)
#pragma unroll
                    for (int q = 0; q < 4; ++q) {
                        u32x2 w; w[0] = pk2(z[kb][4 * q], z[kb][4 * q + 1]); w[1] = pk2(z[kb][4 * q + 2], z[kb][4 * q + 3]);
                        *(LAS u32x2*)(xt + (32 * kb + pj) * 72 + (8 * q + 4 * hf) * 2) = w;
                    }
                f32x16 y;
#pragma unroll
                for (int r = 0; r < 16; ++r) y[r] = 0.f;
#pragma unroll 2
                for (int kk = 0; kk < 8; ++kk) {
                    const bf16x8 af = as_bf16x8(cts[kk * 64 + lane]);
                    const s16x4 b0 = __builtin_amdgcn_ds_read_tr16_b64_v4i16((LAS s16x4*)(xt + traddr + (16 * kk) * 72));
                    const s16x4 b1 = __builtin_amdgcn_ds_read_tr16_b64_v4i16((LAS s16x4*)(xt + traddr + (16 * kk + 4) * 72));
                    bf16x8 bf; bf[0] = b0[0]; bf[1] = b0[1]; bf[2] = b0[2]; bf[3] = b0[3]; bf[4] = b1[0]; bf[5] = b1[1]; bf[6] = b1[2]; bf[7] = b1[3];
                    y = MFMA32(af, bf, y);
                }
                const f32x4 dv0 = *(const f32x4*)(P.ssm_d + g * GH + 8 * hf), dv1 = *(const f32x4*)(P.ssm_d + g * GH + 8 * hf + 4);
                float o[8];
#pragma unroll
                for (int q = 0; q < 2; ++q)
#pragma unroll
                    for (int sx = 0; sx < 4; ++sx) {
                        const float yv = y[4 * q + sx] + y[4 * (q + 2) + sx] + (q ? dv1[sx] : dv0[sx]) * u[q][sx];
                        o[4 * q + sx] = gelu_tanh(yv);
                    }
                u32x4 w; w[0] = pk2(o[0], o[1]); w[1] = pk2(o[2], o[3]); w[2] = pk2(o[4], o[5]); w[3] = pk2(o[6], o[7]);
                *(u32x4*)(Gout + (size_t)(t0 + 32 * tb + pj) * SW + g * GH + 8 * hf) = w;
            }
        }
        if (!PASSB) {
            const float2 fv = make_float2(hf ? cr[1] : cr[0], hf ? ci[1] : ci[0]);
            if (LOCAL) Fl[(wid + 8 * k4) * 64 + lane] = (f32x2v){fv.x, fv.y}; else F[(size_t)c * 4096 + g * 64 + lane] = fv;
        }
      }
      if (!PASSB && LOCAL) {
          __syncthreads();
          if (wid == 0) {
              const float2 lm = l64g[g * 64 + lane];
              float xr = 0.f, xi = 0.f;
              for (int ci2 = 0; ci2 < 32; ++ci2) {
                  const f32x2v f = Fl[ci2 * 64 + lane];
                  Fl[ci2 * 64 + lane] = (f32x2v){xr, xi};
                  const float nr = CMUL_R(lm.x, lm.y, xr, xi) + f.x, ni = CMUL_I(lm.x, lm.y, xr, xi) + f.y; xr = nr; xi = ni;
              }
              QT[((size_t)g * 4 + cq) * 64 + lane] = make_float2(xr, xi);
          }
      }
    }
}

__device__ __forceinline__ void carry_phase(const Params& P) {
    unsigned char* ws = P.ws;
    const int tid = opaque_tid();
    if (tid >= 64) return;
    const float2* F = (const float2*)(ws + WS_F); float2* Cin = (float2*)(ws + WS_CIN); const float2* l64 = (const float2*)(ws + WS_LAM64);
    const int per = (NG * NP + (int)gridDim.x - 1) / (int)gridDim.x;
    for (int k0 = 0; k0 < per; k0 += 64) {
        const int li = k0 + tid, gp = blockIdx.x * per + li;
        if (li >= per || gp >= NG * NP) continue;
        const float2 lm = l64[gp];
        float xr = 0.f, xi = 0.f;
#pragma unroll 1
        for (int c0 = 0; c0 < NCH; c0 += 32) {
            float2 f[32];
#pragma unroll
            for (int k = 0; k < 32; ++k) f[k] = F[(size_t)(c0 + k) * 4096 + gp];
#pragma unroll
            for (int k = 0; k < 32; ++k) {
                Cin[(size_t)(c0 + k) * 4096 + gp] = make_float2(xr, xi);
                const float nr = lm.x * xr - lm.y * xi + f[k].x, ni = lm.x * xi + lm.y * xr + f[k].y;
                xr = nr; xi = ni;
            }
        }
    }
}

__device__ __forceinline__ void sconv_load(const bf16_t* Gb, int t, int lane, u32x4 (&r)[6]) {
    const bf16_t* row = Gb + (size_t)t * (3 * CW) + 8 * lane;
#pragma unroll
    for (int i = 0; i < 2; ++i) { r[3 * i] = *(const u32x4*)(row + 512 * i); r[3 * i + 1] = *(const u32x4*)(row + CW + 512 * i); r[3 * i + 2] = *(const u32x4*)(row + 2 * CW + 512 * i); }
}
__device__ __forceinline__ void sconv_prod(const u32x4 (&r)[6], float (&p)[16]) {
#pragma unroll
    for (int i = 0; i < 2; ++i)
#pragma unroll
        for (int q = 0; q < 4; ++q) { p[8 * i + 2 * q] = bflo(r[3 * i + 1][q]) * bflo(r[3 * i + 2][q]); p[8 * i + 2 * q + 1] = bfhi(r[3 * i + 1][q]) * bfhi(r[3 * i + 2][q]); }
}
template <bool ALLW = false>
__device__ __forceinline__ void sconv_phase(const Params& P, int b0, int nbk) {
    unsigned char* ws = P.ws;
    if ((int)blockIdx.x < b0) return;
    const int tid = opaque_tid(), wid = tid >> 6, lane = tid & 63;
    const bf16_t* Gb = (const bf16_t*)(ws + WS_GBCV);
    bf16_t* Y = (bf16_t*)(ws + WS_YMIX);
    if (!ALLW && wid == 0) return;
    const int NWV = ALLW ? 8 : 7, W = nbk * NWV, w = ((int)blockIdx.x - b0) * NWV + (ALLW ? wid : wid - 1), R = (L + W - 1) / W, tb = w * R, te = (tb + R < L) ? tb + R : L;
    if (tb >= te) return;
    float w0[16], w1[16], w2[16], gn[16];
#pragma unroll
    for (int i = 0; i < 2; ++i)
#pragma unroll
        for (int q = 0; q < 2; ++q) {
            const int c = 8 * lane + 512 * i + 4 * q;
            const f32x4 a = *(const f32x4*)(P.sconv_w + c), b = *(const f32x4*)(P.sconv_w + CW + c), d = *(const f32x4*)(P.sconv_w + 2 * CW + c), g = *(const f32x4*)(P.ncg + c);
#pragma unroll
            for (int j = 0; j < 4; ++j) { w0[8 * i + 4 * q + j] = a[j]; w1[8 * i + 4 * q + j] = b[j]; w2[8 * i + 4 * q + j] = d[j]; gn[8 * i + 4 * q + j] = g[j]; }
        }
    float p2[16], p1[16];
    u32x4 r[6];
#pragma unroll
    for (int k = 0; k < 16; ++k) { p2[k] = 0.f; p1[k] = 0.f; }
    if (tb >= 2) { sconv_load(Gb, tb - 2, lane, r); sconv_prod(r, p2); }
    if (tb >= 1) { sconv_load(Gb, tb - 1, lane, r); sconv_prod(r, p1); }
    sconv_load(Gb, tb, lane, r);
    for (int t = tb; t < te; ++t) {
        u32x4 rn[6];
        const int tn = (t + 1 < te) ? t + 1 : t;
        sconv_load(Gb, tn, lane, rn);
        float p0[16], y[16]; float ss = 0.f;
        sconv_prod(r, p0);
#pragma unroll
        for (int i = 0; i < 2; ++i)
#pragma unroll
            for (int q = 0; q < 4; ++q) {
                const int k = 8 * i + 2 * q;
                y[k] = bflo(r[3 * i][q]) * (w0[k] * p2[k] + w1[k] * p1[k] + w2[k] * p0[k]);
                y[k + 1] = bfhi(r[3 * i][q]) * (w0[k + 1] * p2[k + 1] + w1[k + 1] * p1[k + 1] + w2[k + 1] * p0[k + 1]);
                ss += y[k] * y[k] + y[k + 1] * y[k + 1];
            }
#pragma unroll
        for (int o = 1; o < 64; o <<= 1) ss += __shfl_xor(ss, o);
        const float sc = rsqrtf(ss * (1.0f / CW) + RMS_EPS);
#pragma unroll
        for (int i = 0; i < 2; ++i) {
            u32x4 o;
#pragma unroll
            for (int q = 0; q < 4; ++q) o[q] = pk2(y[8 * i + 2 * q] * sc * gn[8 * i + 2 * q], y[8 * i + 2 * q + 1] * sc * gn[8 * i + 2 * q + 1]);
            *(u32x4*)(Y + (size_t)t * D + CW + 8 * lane + 512 * i) = o;
        }
#pragma unroll
        for (int k = 0; k < 16; ++k) { p2[k] = p1[k]; p1[k] = p0[k]; }
#pragma unroll
        for (int k = 0; k < 6; ++k) r[k] = rn[k];
    }
}

__device__ __forceinline__ void glu_sconv_phase(const Params& P) {
    unsigned char* ws = P.ws;
    gemm_phase<SW, EPI_GLU>(P, (const bf16_t*)(ws + WS_G), (const bf16_t*)(ws + WS_WGLU), L / BM, SW / BM);
    constexpr int S0 = S_IN + S_GLU + S_OUT + S_GU_EARLY;
    __syncthreads();
    convert_strips(P, S0, S_EARLY, 1, (unsigned*)(ws + WS_BAR) + XCD_BAR_WORDS);
}

__device__ __forceinline__ void ffn_phase(const Params& P) {
    unsigned char* ws = P.ws;
    constexpr int NM = 33, NN = 2 * DFF / BM;
    gemm_phase<D, EPI_FFN>(P, (const bf16_t*)(ws + WS_H1B), (const bf16_t*)(ws + WS_WGU), NM, NN);
    const int G = gridDim.x, rem = (NM * NN) % G, b = blockIdx.x;
    __syncthreads();
    if (rem == 0) convert_strips(P, S_EARLY + b, S_EARLY + S_D, G);
    else if (b >= rem) convert_strips(P, S_EARLY + (b - rem), S_EARLY + S_D, G - rem);
}

template <bool FIRST>
__device__ __forceinline__ void ln_phase(const Params& P) {
    unsigned char* ws = P.ws;
    const int tid = opaque_tid(), wid = tid >> 6, lane = tid & 63;
    const float* st = (const float*)(ws + (FIRST ? WS_ST1 : WS_ST2));
    const float* gam = FIRST ? P.ln1g : P.ln2g; const float* bet = FIRST ? P.ln1b : P.ln2b;
    bf16_t* HB = (bf16_t*)(ws + WS_H1B);
    for (int t = blockIdx.x * 8 + wid; t < L; t += gridDim.x * 8) {
        const float mean = st[2 * t] * (1.0f / D);
        const float var = fmaxf(st[2 * t + 1] * (1.0f / D) - mean * mean, 0.f);
        const float rstd = rsqrtf(var + LN_EPS);
        float* row = P.out + (size_t)t * D;
#pragma unroll
        for (int i = 0; i < 4; ++i) {
            const int c = 8 * lane + 512 * i;
            const f32x4 a = *(const f32x4*)(row + c), b = *(const f32x4*)(row + c + 4);
            const f32x4 g0 = *(const f32x4*)(gam + c), g1 = *(const f32x4*)(gam + c + 4), b0 = *(const f32x4*)(bet + c), b1 = *(const f32x4*)(bet + c + 4);
            f32x4 o0, o1;
#pragma unroll
            for (int j = 0; j < 4; ++j) { o0[j] = (a[j] - mean) * rstd * g0[j] + b0[j]; o1[j] = (b[j] - mean) * rstd * g1[j] + b1[j]; }
            *(f32x4*)(row + c) = o0; *(f32x4*)(row + c + 4) = o1;
            if (FIRST) { u32x4 o; o[0] = pk2(o0[0], o0[1]); o[1] = pk2(o0[2], o0[3]); o[2] = pk2(o1[0], o1[1]); o[3] = pk2(o1[2], o1[3]); *(u32x4*)(HB + (size_t)t * D + c) = o; }
        }
    }
}


#define XB_SPIN_CAP (1u << 22)
__device__ __forceinline__ unsigned xb_ld(unsigned* p)              { return __hip_atomic_load(p, __ATOMIC_RELAXED, __HIP_MEMORY_SCOPE_AGENT); }
__device__ __forceinline__ unsigned xb_add(unsigned* p, unsigned v) { return __hip_atomic_fetch_add(p, v, __ATOMIC_RELAXED, __HIP_MEMORY_SCOPE_AGENT); }
__device__ __forceinline__ unsigned xb_xcc_id() { return (unsigned)__builtin_amdgcn_s_getreg((3 << 11) | 20) & 0xFu; }
#define XB_SPIN(cond, bar) do { unsigned _sp = 0; while (cond) { __builtin_amdgcn_s_sleep(1); \
    if ((++_sp & 255u) == 0u) { if (xb_ld(&(bar)[XB_TMO])) break; if (_sp > XB_SPIN_CAP) { atomicAdd(&(bar)[XB_TMO], 1u); break; } } } } while (0)
struct XcdBarrier { unsigned* bar; unsigned x; volatile LAS unsigned* st; };
__device__ __forceinline__ XcdBarrier xcd_barrier_post(unsigned* bar, volatile LAS unsigned* st) {
    XcdBarrier b; b.bar = bar; b.x = xb_xcc_id(); b.st = st;
    if (threadIdx.x == 0) (void)xb_add(&bar[XB_XCNT(b.x)], 1u);
    return b;
}
__device__ __forceinline__ void xcd_barrier_complete(unsigned* bar, unsigned x, unsigned& nloc, unsigned& nx) {
    const unsigned G = gridDim.x * gridDim.y * gridDim.z;
    unsigned sum, cnt, mine, sp = 0u;
    for (;;) {
        sum = 0u; cnt = 0u; mine = 0u;
#pragma unroll
        for (unsigned j = 0; j < 16; ++j) { const unsigned c = xb_ld(&bar[XB_XCNT(j)]); sum += c; cnt += (c > 0u) ? 1u : 0u; mine = (j == x) ? c : mine; }
        if (sum == G) break;
        __builtin_amdgcn_s_sleep(1);
        if ((++sp & 255u) == 0u) { if (xb_ld(&bar[XB_TMO])) break; if (sp > XB_SPIN_CAP) { atomicAdd(&bar[XB_TMO], 1u); break; } }
    }
    nloc = mine > 0u ? mine : 1u; nx = cnt > 0u ? cnt : 1u;
}
__device__ __forceinline__ void xcd_barrier(unsigned char* wsb) {
    asm volatile("s_waitcnt vmcnt(0)" ::: "memory");
    __syncthreads();
    if (threadIdx.x == 0) {
        XcdBarrier b; b.bar = (unsigned*)(wsb + WS_BAR); b.x = xb_xcc_id(); b.st = (volatile LAS unsigned*)(LAS unsigned char*)(smem + 128 * 1024);
        unsigned* bar = b.bar;
        __builtin_amdgcn_s_waitcnt(0);
        unsigned nloc = b.st[0], nx = b.st[1];
        if (nloc == 0u) { xcd_barrier_complete(bar, b.x, nloc, nx); b.st[0] = nloc; b.st[1] = nx; }
        const unsigned old = xb_add(&bar[XB_XSUB(b.x)], 1u);
        const unsigned gen = old / nloc;
        if (old + 1u == (gen + 1u) * nloc) {
            __builtin_amdgcn_fence(__ATOMIC_RELEASE, "agent");
            asm volatile("s_waitcnt vmcnt(0)" ::: "memory");
            const unsigned og = xb_add(&bar[XB_TOP], 1u);
            const unsigned tg = og / nx;
            if (og + 1u == (tg + 1u) * nx) xb_add(&bar[XB_TOPGEN], 1u);
            else XB_SPIN(xb_ld(&bar[XB_TOPGEN]) == tg, bar);
            __builtin_amdgcn_fence(__ATOMIC_ACQUIRE, "agent");
            xb_add(&bar[XB_XGEN(b.x)], 1u);
            asm volatile("s_waitcnt vmcnt(0)" ::: "memory");
        } else {
            XB_SPIN(xb_ld(&bar[XB_XGEN(b.x)]) == gen, bar);
            __builtin_amdgcn_fence(__ATOMIC_ACQUIRE, "agent");
            asm volatile("s_waitcnt vmcnt(0)" ::: "memory");
        }
    }
    __syncthreads();
}

template <bool COOP, bool FUSELN>
__global__ void __launch_bounds__(512) fwd_kernel(Params P, int ph_lo, int ph_hi) {
    unsigned char* ws = P.ws;
#ifndef PHMASK
#define PHMASK 0x7ff
#endif
#define RUN_PHASE(k, body) do { if ((PHMASK & (1 << k)) && (COOP || (ph_lo <= k && k < ph_hi))) { body; } if (COOP && k < 10) xcd_barrier(P.ws); } while (0)
    if (COOP) {
        unsigned* bar = (unsigned*)(ws + WS_BAR);
        volatile LAS unsigned* st = (volatile LAS unsigned*)(LAS unsigned char*)(smem + 128 * 1024);
        if (threadIdx.x == 0) { st[0] = 0u; st[1] = 0u; }
        __syncthreads();
        (void)xcd_barrier_post(bar, st);
        if (ph_hi > 1000) cg::this_grid().sync();
        phase0(P);
        xcd_barrier(P.ws);
    } else {
        if (ph_lo == 0) phase0(P);
    }
    RUN_PHASE(1, (gemm_phase<D, EPI_PROJ>(P, (const bf16_t*)(ws + WS_XB), (const bf16_t*)(ws + WS_WIN), L / BM, DIN / BM)));
    if (COOP && FUSELN) {
        ssm_phase<false, true>(P);
        xcd_barrier(P.ws);
        ssm_phase<true, true>(P);
        sconv_phase<true>(P, 0, gridDim.x);
        xcd_barrier(P.ws);
    } else {
        RUN_PHASE(2, ssm_phase<false>(P));
        RUN_PHASE(3, carry_phase(P); sconv_phase(P, 0, gridDim.x));
        RUN_PHASE(4, ssm_phase<true>(P));
    }
    RUN_PHASE(5, (glu_sconv_phase(P)));
    if (COOP && FUSELN) {
        gemm_phase<D, EPI_OUT, true>(P, (const bf16_t*)(ws + WS_YMIX), (const bf16_t*)(ws + WS_WOUT), L / BM, D / BM);
        xcd_barrier(P.ws);
    } else {
        RUN_PHASE(6, (gemm_phase<D, EPI_OUT>(P, (const bf16_t*)(ws + WS_YMIX), (const bf16_t*)(ws + WS_WOUT), L / BM, D / BM)));
        RUN_PHASE(7, ln_phase<true>(P));
    }
    RUN_PHASE(8, ffn_phase(P));
    if (COOP && FUSELN) {
        gemm_phase<DFF, EPI_DOWN, true>(P, (const bf16_t*)(ws + WS_ACT), (const bf16_t*)(ws + WS_WD), L / BM, D / BM);
    } else {
        RUN_PHASE(9, (gemm_phase<DFF, EPI_DOWN>(P, (const bf16_t*)(ws + WS_ACT), (const bf16_t*)(ws + WS_WD), L / BM, D / BM)));
        RUN_PHASE(10, ln_phase<false>(P));
    }
}

constexpr int LDS_BYTES = 128 * 1024 + 64;

extern "C" void kernel_launch(void* const* d_in, const int* in_sizes, int n_in, void* d_out, int out_size, void* d_ws, size_t ws_size, hipStream_t stream) {
    static int grid = 0;
    if (grid == 0) {
        int dev = 0, cus = 0, per_cu = 0;
        hipGetDevice(&dev);
        hipDeviceGetAttribute(&cus, hipDeviceAttributeMultiprocessorCount, dev);
        hipFuncSetAttribute((const void*)fwd_kernel<true, true>, hipFuncAttributeMaxDynamicSharedMemorySize, LDS_BYTES);
        hipFuncSetAttribute((const void*)fwd_kernel<true, false>, hipFuncAttributeMaxDynamicSharedMemorySize, LDS_BYTES);
        hipFuncSetAttribute((const void*)fwd_kernel<false, false>, hipFuncAttributeMaxDynamicSharedMemorySize, LDS_BYTES);
        hipOccupancyMaxActiveBlocksPerMultiprocessor(&per_cu, (const void*)fwd_kernel<true, true>, 512, LDS_BYTES);
        if (per_cu < 1) per_cu = 1;
        grid = cus * per_cu;
        if (n_in != 25 || ws_size < 256 * MiB) fprintf(stderr, "kernel_launch: unexpected n_in %d / ws_size %zu\n", n_in, ws_size);
        (void)hipGetLastError();
    }
    Params p{};
    const float** pp = (const float**)&p;
    for (int i = 0; i < 25; ++i) pp[i] = (const float*)d_in[i];
    p.out = (float*)d_out; p.ws = (unsigned char*)d_ws;
    (void)hipMemsetAsync((unsigned char*)d_ws + WS_BAR, 0, XCD_BAR_WORDS * 4 + 256, stream);
#if N_LAUNCH == 1
    int lo = 0, hi = 11;
    void* args[] = {&p, &lo, &hi};
    const bool fuse = (grid == (L / BM) * (D / BM));
    hipError_t e = hipLaunchCooperativeKernel(fuse ? (const void*)fwd_kernel<true, true> : (const void*)fwd_kernel<true, false>, dim3(grid), dim3(512), args, LDS_BYTES, stream);
    if (e != hipSuccess) fprintf(stderr, "cooperative launch failed: %s (grid %d)\n", hipGetErrorString(e), grid);
#else
    for (int ph = 0; ph < 11; ++ph) hipLaunchKernelGGL(fwd_kernel<false, false>, dim3(grid), dim3(512), LDS_BYTES, stream, p, ph, ph + 1);
#endif
}
```

```cpp
#include <hip/hip_runtime.h>
#include <hip/hip_cooperative_groups.h>
#include <cstdio>
#include <cstdint>
namespace cg = cooperative_groups;

#ifndef PREISSUE
#define PREISSUE 0
#endif
#ifndef N_LAUNCH
#define N_LAUNCH 1
#endif

typedef unsigned short bf16_t;
using bf16x8 = __attribute__((ext_vector_type(8))) short;
using f32x4 = __attribute__((ext_vector_type(4))) float;
using u32x4 = __attribute__((ext_vector_type(4))) unsigned;
using u32x2 = __attribute__((ext_vector_type(2))) unsigned;

constexpr int L = 8192, D = 2048, DIN = 4096, SW = 1024, CW = 1024, NG = 64, GH = 16, NP = 64, DFF = 5632;
constexpr int TCH = 64, NCH = L / TCH;
constexpr float ALPHA = 1.189207115002721f;
constexpr float LN_EPS = 1e-5f, RMS_EPS = 1e-6f;

constexpr size_t MiB = 1024 * 1024;
constexpr size_t WS_WIN = 0, WS_WGLU = 16 * MiB, WS_WOUT = 18 * MiB, WS_WGU = 26 * MiB, WS_WD = 70 * MiB;
constexpr size_t WS_XB = 92 * MiB, WS_YMIX = 92 * MiB;
constexpr size_t WS_U = 124 * MiB, WS_H1B = 124 * MiB;
constexpr size_t WS_GBCV = 156 * MiB, WS_ACT = 156 * MiB;
constexpr size_t WS_G = 204 * MiB;
constexpr size_t WS_F = 244 * MiB, WS_LTP = 248 * MiB, WS_BBAR = 252 * MiB, WS_CT = 252 * MiB + 512 * 1024;
constexpr size_t WS_LAMB = 253 * MiB, WS_LAM64 = 253 * MiB + 64 * 1024, WS_CIN = 248 * MiB, WS_ROWSS = 253 * MiB + 256 * 1024, WS_ST1 = WS_ROWSS + 32 * 1024, WS_ST2 = WS_ST1 + 64 * 1024, WS_BAR = WS_ROWSS + 256 * 1024;

struct Params {
    const float *x, *w_in, *lam_re, *lam_im, *log_dt, *b_re, *b_im, *c_re, *c_im, *ssm_d, *glu_w, *glu_b, *sconv_w, *nsg, *ncg,
        *w_out, *ln1g, *ln1b, *wg, *wu, *fcw, *fcb, *wd, *ln2g, *ln2b;
    float* out;
    unsigned char* ws;
};

extern __shared__ __attribute__((aligned(16))) unsigned char smem[];

#define LAS __attribute__((address_space(3)))
#define XB_TMO      128
#define XB_XCNT(j)  (256  + 64 * (j))
#define XB_XSUB(j)  (1280 + 64 * (j))
#define XB_XGEN(j)  (2304 + 64 * (j))
#define XB_TOP      3328
#define XB_TOPGEN   3392
#define XCD_BAR_WORDS 3456
__device__ __forceinline__ int opaque_tid() { int t = threadIdx.x; asm volatile("" : "+v"(t)); return t; }
__device__ __forceinline__ unsigned pk2(float lo, float hi) { unsigned r; asm volatile("v_cvt_pk_bf16_f32 %0, %1, %2" : "=v"(r) : "v"(lo), "v"(hi)); return r; }
__device__ __forceinline__ float bflo(unsigned w) { return __uint_as_float(w << 16); }
__device__ __forceinline__ float bfhi(unsigned w) { return __uint_as_float(w & 0xffff0000u); }
__device__ __forceinline__ float sigmoidf_(float z) { return __builtin_amdgcn_rcpf(1.0f + __expf(-z)); }
__device__ __forceinline__ float gelu_tanh(float y) { float z = 0.7978845608028654f * (y + 0.044715f * y * y * y); return y * sigmoidf_(2.0f * z); }

__device__ __forceinline__ void dsincos(double th, double& s, double& c) {
    const double TWO_PI_HI = 6.283185307179586, TWO_PI_LO = 2.4492935982947064e-16;
    double n = rint(th * 0.15915494309189535);
    double r = fma(-n, TWO_PI_HI, th); r = fma(-n, TWO_PI_LO, r);
    double q = rint(r * 0.6366197723675814);
    double t = fma(-q, 1.5707963267948966, r); t = fma(-q, 6.123233995736766e-17, t);
    double t2 = t * t;
    double sp = t * (1.0 + t2 * (-1.0 / 6 + t2 * (1.0 / 120 + t2 * (-1.0 / 5040 + t2 * (1.0 / 362880 + t2 * (-1.0 / 39916800 + t2 * (1.0 / 6227020800.0)))))));
    double cp = 1.0 + t2 * (-0.5 + t2 * (1.0 / 24 + t2 * (-1.0 / 720 + t2 * (1.0 / 40320 + t2 * (-1.0 / 3628800 + t2 * (1.0 / 479001600.0 + t2 * (-1.0 / 87178291200.0)))))));
    int qi = ((int)q) & 3;
    s = (qi == 0) ? sp : (qi == 1) ? cp : (qi == 2) ? -sp : -cp;
    c = (qi == 0) ? cp : (qi == 1) ? -sp : (qi == 2) ? -cp : sp;
}
__device__ __forceinline__ double dexp(double x) {
    if (x < -700.0) return 0.0;
    double k = rint(x * 1.4426950408889634);
    double r = fma(-k, 0.6931471805599453, x); r = fma(-k, 2.3190468138462996e-17, r);
    double p = 1.0 + r * (1.0 + r * (0.5 + r * (1.0 / 6 + r * (1.0 / 24 + r * (1.0 / 120 + r * (1.0 / 720 + r * (1.0 / 5040 + r * (1.0 / 40320 + r * (1.0 / 362880 + r * (1.0 / 3628800 + r * (1.0 / 39916800 + r * (1.0 / 479001600.0))))))))))));
    long long bits = ((long long)((int)k + 1023)) << 52;
    return p * __longlong_as_double(bits);
}

struct Strip { const float* W; bf16_t* WT; int K, N, mode, k0, n0; };
constexpr int S_IN = (D / 64) * (DIN / 256), S_GLU = (SW / 64) * (SW / 256), S_OUT = (D / 64) * (D / 256), S_G = (D / 64) * (DFF / 256), S_D = (DFF / 64) * (D / 256);
constexpr int S_EARLY = S_IN + S_GLU + S_OUT + 2 * S_G;
constexpr int S_GU_EARLY = 0;
__device__ __forceinline__ Strip strip_desc(const Params& P, int sidx) {
    unsigned char* ws = P.ws;
    Strip t; int r = sidx;
    if (r < S_IN) { t.W = P.w_in; t.WT = (bf16_t*)(ws + WS_WIN); t.K = D; t.N = DIN; t.mode = 0; }
    else if ((r -= S_IN) < S_GLU) { t.W = P.glu_w; t.WT = (bf16_t*)(ws + WS_WGLU); t.K = SW; t.N = SW; t.mode = 0; }
    else if ((r -= S_GLU) < S_OUT) { t.W = P.w_out; t.WT = (bf16_t*)(ws + WS_WOUT); t.K = D; t.N = D; t.mode = 0; }
    else if ((r -= S_OUT) < S_G) { t.W = P.wg; t.WT = (bf16_t*)(ws + WS_WGU); t.K = D; t.N = DFF; t.mode = 1; }
    else if ((r -= S_G) < S_G) { t.W = P.wu; t.WT = (bf16_t*)(ws + WS_WGU); t.K = D; t.N = DFF; t.mode = 2; }
    else { r -= S_G; t.W = P.wd; t.WT = (bf16_t*)(ws + WS_WD); t.K = DFF; t.N = D; t.mode = 0; }
    const int nk = t.K / 64;
    t.k0 = (r % nk) * 64; t.n0 = (r / nk) * 256;
    return t;
}
__device__ __forceinline__ void strip_load(const Strip& t, int tid, f32x4 (&v)[8]) {
    const float* src = t.W + (size_t)(t.k0 + (tid >> 6)) * t.N + t.n0 + 4 * (tid & 63);
#pragma unroll
    for (int i = 0; i < 8; ++i) v[i] = __builtin_nontemporal_load((const f32x4*)(src + (size_t)(8 * i) * t.N));
}
__device__ __forceinline__ void strip_lds_write(float* tile, int tid, const f32x4 (&v)[8]) {
#pragma unroll
    for (int i = 0; i < 8; ++i) *(f32x4*)(tile + ((tid >> 6) + 8 * i) * 256 + ((4 * (tid & 63)) ^ (i << 3))) = v[i];
}
__device__ __forceinline__ void strip_store(const float* tile, int tid, const Strip& cur) {
    const int kc = tid & 7;
#pragma unroll
    for (int j = 0; j < 4; ++j) {
        const int n = 64 * j + (tid >> 3);
        const float* q = tile + (8 * kc) * 256 + (n ^ (kc << 3));
        u32x4 o;
        o[0] = pk2(q[0 * 256], q[1 * 256]); o[1] = pk2(q[2 * 256], q[3 * 256]); o[2] = pk2(q[4 * 256], q[5 * 256]); o[3] = pk2(q[6 * 256], q[7 * 256]);
        const int nn = cur.n0 + n;
        int drow = nn;
        if (cur.mode == 1) drow = 256 * (nn >> 7) + (nn & 127);
        if (cur.mode == 2) drow = 256 * (nn >> 7) + 128 + (nn & 127);
        *(u32x4*)(cur.WT + (size_t)drow * cur.K + cur.k0 + 8 * kc) = o;
    }
}
__device__ __forceinline__ int strip_next(int cur, int step, unsigned* ctr, int first, int tid) {
    if (!ctr) return cur + step;
    LAS int* slot = (LAS int*)((LAS unsigned char*)smem + 2 * 65536 - 64);
    __syncthreads();
    if (tid == 0) *slot = first + (int)__hip_atomic_fetch_add(ctr, 1u, __ATOMIC_RELAXED, __HIP_MEMORY_SCOPE_AGENT);
    __syncthreads();
    return *slot;
}
__device__ __forceinline__ void convert_strips(const Params& P, int first, int last, int step, unsigned* ctr = nullptr) {
    float* tile = (float*)smem;
    const int tid = opaque_tid();
    f32x4 va[8], vb[8];
    int sa = ctr ? strip_next(0, 0, ctr, first, tid) : first;
    if (sa >= last) return;
    Strip da = strip_desc(P, sa);
    strip_load(da, tid, va);
    int sb = strip_next(sa, step, ctr, first, tid);
    Strip db = da;
    if (sb < last) { db = strip_desc(P, sb); strip_load(db, tid, vb); }
    for (;;) {
        strip_lds_write(tile, tid, va);
        __syncthreads();
        const Strip ca = da;
        sa = (sb < last) ? strip_next(sb, step, ctr, first, tid) : last;
        if (sa < last) { da = strip_desc(P, sa); strip_load(da, tid, va); }
        strip_store(tile, tid, ca);
        __syncthreads();
        if (sb >= last) break;
        strip_lds_write(tile, tid, vb);
        __syncthreads();
        const Strip cb = db;
        sb = (sa < last) ? strip_next(sa, step, ctr, first, tid) : last;
        if (sb < last) { db = strip_desc(P, sb); strip_load(db, tid, vb); }
        strip_store(tile, tid, cb);
        __syncthreads();
        if (sa >= last) break;
    }
}

__device__ __forceinline__ void phase0(const Params& P) {
    unsigned char* ws = P.ws;
    const int nb = gridDim.x, b = blockIdx.x, tid = opaque_tid();
    convert_strips(P, b, S_IN + S_GLU + S_OUT + S_GU_EARLY, nb);
    const size_t gt = (size_t)b * 512 + tid, ngt = (size_t)nb * 512;
    {
        u32x4* xb = (u32x4*)(ws + WS_XB);
        for (size_t e0 = gt; e0 < (size_t)L * D / 8; e0 += 4 * ngt) {
            f32x4 a[4], c[4];
#pragma unroll
            for (int q = 0; q < 4; ++q) { const size_t e = e0 + q * ngt; if (e < (size_t)L * D / 8) { a[q] = __builtin_nontemporal_load((const f32x4*)(P.x + e * 8)); c[q] = __builtin_nontemporal_load((const f32x4*)(P.x + e * 8 + 4)); } }
#pragma unroll
            for (int q = 0; q < 4; ++q) { const size_t e = e0 + q * ngt; if (e < (size_t)L * D / 8) {
                u32x4 o; o[0] = pk2(a[q][0], a[q][1]); o[1] = pk2(a[q][2], a[q][3]); o[2] = pk2(c[q][0], c[q][1]); o[3] = pk2(c[q][2], c[q][3]);
                xb[e] = o; } }
        }
    }
    {
        float* z = (float*)(ws + WS_ROWSS);
        for (size_t e = gt; e < (size_t)L * 5; e += ngt) z[e] = 0.f;
    }
    {
        float2* lamb = (float2*)(ws + WS_LAMB); float2* ltp = (float2*)(ws + WS_LAM64);
        u32x4* BT = (u32x4*)(ws + WS_BBAR); u32x4* CTT = (u32x4*)(ws + WS_CT);
        for (size_t e = gt; e < (size_t)NG * NP; e += ngt) {
            const int g = (int)(e >> 6);
            const double dt = dexp((double)P.log_dt[g]), lr = (double)P.lam_re[e], li = (double)P.lam_im[e];
            const double mag = dexp(lr * dt); double sn, cs; dsincos(li * dt, sn, cs);
            lamb[e] = make_float2((float)(mag * cs), (float)(mag * sn));
        }
        for (size_t e = gt; e < (size_t)NG * 4 * 64; e += ngt) {
            const int ln = (int)(e & 63), kb = (int)((e >> 6) & 3), g = (int)(e >> 8);
            const int pp = (ln & 31) + 32 * (kb >> 1), gp = g * 64 + pp, h0 = 8 * (ln >> 5);
            const double dt = dexp((double)P.log_dt[g]), lr = (double)P.lam_re[gp], li = (double)P.lam_im[gp];
            const double mag = dexp(lr * dt); double sn, cs; dsincos(li * dt, sn, cs);
            const double nr = mag * cs - 1.0, ni = mag * sn, den = lr * lr + li * li;
            const double cr = (nr * lr + ni * li) / den, ci = (ni * lr - nr * li) / den;
            float v[8];
#pragma unroll
            for (int q = 0; q < 8; ++q) {
                const double br = (double)P.b_re[(size_t)gp * GH + h0 + q], bi = (double)P.b_im[(size_t)gp * GH + h0 + q];
                v[q] = (kb & 1) ? (float)(cr * bi + ci * br) : (float)(cr * br - ci * bi);
            }
            u32x4 hi, lo;
#pragma unroll
            for (int q = 0; q < 4; ++q) { hi[q] = pk2(v[2 * q], v[2 * q + 1]); lo[q] = pk2(v[2 * q] - bflo(hi[q]), v[2 * q + 1] - bfhi(hi[q])); }
            BT[((size_t)(g * 4 + kb) * 2 + 0) * 64 + ln] = hi; BT[((size_t)(g * 4 + kb) * 2 + 1) * 64 + ln] = lo;
        }
        for (size_t e = gt; e < (size_t)NG * 8 * 64; e += ngt) {
            const int ln = (int)(e & 63), kk = (int)((e >> 6) & 7), g = (int)(e >> 9);
            const int ii = ln & 15, lopart = (ln >> 4) & 1, h = 8 * ((ii >> 2) & 1) + 4 * (ii >> 3) + (ii & 3);
            float v[8];
#pragma unroll
            for (int q = 0; q < 8; ++q) {
                const int kl = 16 * kk + 8 * (ln >> 5) + q, kb = kl >> 5, pp = (kl & 31) + 32 * (kb >> 1);
                const float cv = (kb & 1) ? -P.c_im[((size_t)g * GH + h) * NP + pp] : P.c_re[((size_t)g * GH + h) * NP + pp];
                v[q] = cv;
            }
            u32x4 o;
#pragma unroll
            for (int q = 0; q < 4; ++q) {
                const unsigned hi = pk2(v[2 * q], v[2 * q + 1]);
                o[q] = lopart ? pk2(v[2 * q] - bflo(hi), v[2 * q + 1] - bfhi(hi)) : hi;
            }
            CTT[e] = o;
        }
        for (size_t e = gt; e < (size_t)NG * NP; e += ngt) {
            const int gp = (int)e, g = gp >> 6;
            const double dt = dexp((double)P.log_dt[g]), lr = (double)P.lam_re[gp], li = (double)P.lam_im[gp];
            const double sc = dt * (double)TCH;
            const double mag = dexp(lr * sc); double sn, cs; dsincos(li * sc, sn, cs);
            ltp[e] = make_float2((float)(mag * cs), (float)(mag * sn));
        }
    }
}

constexpr int BM = 256, BK = 64, HALF = 128, HT = HALF * BK, NXCD = 8, WGM = 4;
__device__ __forceinline__ int lds_byte(int r, int c) { int st = (r >> 4) * 2 + (c >> 5), rr = r & 15, cc = c & 31, ob = rr * 64 + cc * 2; return st * 1024 + (ob ^ (((ob >> 9) & 1) << 5)); }
__device__ __forceinline__ void stage_rc(int b, int& R, int& C) { int st = b / 1024, sb = b % 1024, swz = sb ^ (((sb >> 9) & 1) << 5); R = (st >> 1) * 16 + swz / 64; C = (st & 1) * 32 + (swz % 64) / 2; }

enum { EPI_PROJ = 1, EPI_GLU = 2, EPI_OUT = 3, EPI_FFN = 4, EPI_DOWN = 5 };

__device__ __forceinline__ void xcd_barrier(unsigned char* wsb);

template <int K, int EPI, bool FUSE = false>
__device__ __forceinline__ void gemm_phase(const Params& P, const bf16_t* __restrict__ A, const bf16_t* __restrict__ Bt, int nM, int nN) {
    typedef __attribute__((address_space(3))) unsigned char lds_u8;
    lds_u8* lds = (lds_u8*)smem;
    unsigned char* ws = P.ws;
    constexpr int HTB = HT * 2;
#define SA(b, h) (((b) * 2 + (h)) * HTB)
#define SB(b, h) ((4 + (b) * 2 + (h)) * HTB)
#define STAGE_B(bufoff, br, kt) do { const char* _g = (const char*)Bt + ((size_t)(br) * K + (size_t)(kt) * BK) * 2; \
        __builtin_amdgcn_global_load_lds((const unsigned*)(_g + voffB0), (__attribute__((address_space(3))) unsigned*)(lds + (bufoff) + ldsw), 16, 0, 0); \
        __builtin_amdgcn_global_load_lds((const unsigned*)(_g + voffB1), (__attribute__((address_space(3))) unsigned*)(lds + (bufoff) + ldsw + 8192), 16, 0, 0); } while (0)
#define STAGE_A(bufoff, h, kt) do { if (EPI == EPI_FFN) { const char* _g = (const char*)A + (size_t)(kt) * BK * 2; \
        __builtin_amdgcn_global_load_lds((const unsigned*)(_g + aoff[h][0]), (__attribute__((address_space(3))) unsigned*)(lds + (bufoff) + ldsw), 16, 0, 0); \
        __builtin_amdgcn_global_load_lds((const unsigned*)(_g + aoff[h][1]), (__attribute__((address_space(3))) unsigned*)(lds + (bufoff) + ldsw + 8192), 16, 0, 0); \
      } else { const char* _g = (const char*)A + ((size_t)(brow + (h) * HALF) * K + (size_t)(kt) * BK) * 2; \
        __builtin_amdgcn_global_load_lds((const unsigned*)(_g + voffA0), (__attribute__((address_space(3))) unsigned*)(lds + (bufoff) + ldsw), 16, 0, 0); \
        __builtin_amdgcn_global_load_lds((const unsigned*)(_g + voffA1), (__attribute__((address_space(3))) unsigned*)(lds + (bufoff) + ldsw + 8192), 16, 0, 0); } } while (0)
#define STAGE_AX(bufoff, AO, h, kt) do { const char* _g = (const char*)A + (size_t)(kt) * BK * 2; \
        __builtin_amdgcn_global_load_lds((const unsigned*)(_g + AO[h][0]), (__attribute__((address_space(3))) unsigned*)(lds + (bufoff) + ldsw), 16, 0, 0); \
        __builtin_amdgcn_global_load_lds((const unsigned*)(_g + AO[h][1]), (__attribute__((address_space(3))) unsigned*)(lds + (bufoff) + ldsw + 8192), 16, 0, 0); } while (0)
#define LDA(dst, b, h) do { _Pragma("unroll") for (int m = 0; m < 4; ++m) _Pragma("unroll") for (int k = 0; k < 2; ++k) \
        dst[m][k] = *(const __attribute__((address_space(3))) bf16x8*)(lds + SA(b, h) + la_off + m * 2048 + k * 1024); } while (0)
#define LDB(dst, b, h) do { _Pragma("unroll") for (int n = 0; n < 2; ++n) _Pragma("unroll") for (int k = 0; k < 2; ++k) \
        dst[n][k] = *(const __attribute__((address_space(3))) bf16x8*)(lds + SB(b, h) + lb_off + n * 2048 + k * 1024); } while (0)
#define MMA(ai, bj, At_, Bt_) do { __builtin_amdgcn_s_setprio(1); \
        _Pragma("unroll") for (int m = 0; m < 4; ++m) _Pragma("unroll") for (int n = 0; n < 2; ++n) _Pragma("unroll") for (int k = 0; k < 2; ++k) \
            acc[ai][bj][m][n] = __builtin_amdgcn_mfma_f32_16x16x32_bf16(Bt_[n][k], At_[m][k], acc[ai][bj][m][n], 0, 0, 0); \
        __builtin_amdgcn_s_setprio(0); } while (0)
#define WAIT_V(n) asm volatile("s_waitcnt vmcnt(" #n ")" ::: "memory")
#define WAIT_L(n) asm volatile("s_waitcnt lgkmcnt(" #n ")" ::: "memory")
#define BAR __builtin_amdgcn_s_barrier()
#define SCHED __builtin_amdgcn_sched_barrier(0)

    const int tid = opaque_tid(), wid = tid >> 6, wr = wid >> 2;
    const int nwg = nM * nN, G = gridDim.x;
    constexpr int nt = K / BK;

    bool pre = false;
#define TILE_OF(Lw_, pm_, pn_) do { int wgid = (Lw_); \
        { const int q = nwg / NXCD, r = nwg % NXCD, xcd = wgid % NXCD, off = wgid / NXCD; wgid = (xcd < r ? xcd * (q + 1) : r * (q + 1) + (xcd - r) * q) + off; } \
        const int nig = WGM * nN, gid = wgid / nig, fm = gid * WGM, gsz = (nM - fm) < WGM ? (nM - fm) : WGM; \
        pm_ = fm + ((wgid % nig) % gsz); pn_ = (wgid % nig) / gsz; } while (0)
#define FFN_AOFF(AO, brow_) do { _Pragma("unroll") for (int h = 0; h < 2; ++h) { \
        int r0 = (brow_) + h * HALF + sR0, r1 = (brow_) + h * HALF + sR1; \
        r0 = r0 < 0 ? 0 : (r0 > L - 1 ? L - 1 : r0); r1 = r1 < 0 ? 0 : (r1 > L - 1 ? L - 1 : r1); \
        AO[h][0] = (unsigned)(r0 * K + sC0) * 2u; AO[h][1] = (unsigned)(r1 * K + sC1) * 2u; } } while (0)
    for (int it = 0;; ++it) {
        const int Lw = it * G + blockIdx.x;
        if (Lw >= nwg) break;
        const int tidk = opaque_tid(), lanek = tidk & 63, wck = (tidk >> 6) & 3, wrk = tidk >> 8, frk = lanek & 15, fqk = lanek >> 4;
        int sR0, sR1, sC0, sC1;
        stage_rc(tidk * 16, sR0, sC0); stage_rc(tidk * 16 + 8192, sR1, sC1);
        const int sRb0 = (EPI == EPI_FFN || EPI == EPI_PROJ || EPI == EPI_GLU || EPI == EPI_OUT) ? ((sR0 & ~31) + 8 * ((sR0 & 15) >> 2) + 4 * ((sR0 & 31) >> 4) + (sR0 & 3)) : sR0;
        const int sRb1 = (EPI == EPI_FFN || EPI == EPI_PROJ || EPI == EPI_GLU || EPI == EPI_OUT) ? ((sR1 & ~31) + 8 * ((sR1 & 15) >> 2) + 4 * ((sR1 & 31) >> 4) + (sR1 & 3)) : sR1;
        const unsigned voffB0 = (unsigned)(sRb0 * K + sC0) * 2u, voffB1 = (unsigned)(sRb1 * K + sC1) * 2u;
        const unsigned voffA0 = (unsigned)(sR0 * K + sC0) * 2u, voffA1 = (unsigned)(sR1 * K + sC1) * 2u;
        const unsigned ldsw = (unsigned)(tidk >> 6) * 1024u;
        const int la_off = lds_byte(wrk * 64 + frk, fqk * 8), lb_off = lds_byte(wck * 32 + frk, fqk * 8);
        int pm, pn;
        unsigned aoff[2][2];
        TILE_OF(Lw, pm, pn);
        if (EPI == EPI_FFN) FFN_AOFF(aoff, 254 * pm - 2);
        const int brow = (EPI == EPI_FFN) ? (254 * pm - 2) : pm * BM, bcol = pn * BM;
        f32x4 acc[2][2][4][2];
#pragma unroll
        for (int a = 0; a < 2; ++a)
#pragma unroll
            for (int b2 = 0; b2 < 2; ++b2)
#pragma unroll
                for (int m = 0; m < 4; ++m)
#pragma unroll
                    for (int n = 0; n < 2; ++n) acc[a][b2][m][n] = (f32x4){0.f, 0.f, 0.f, 0.f};
        bf16x8 At[4][2], B0[2][2], B1[2][2];

        if (EPI == EPI_FFN && pre) {
            if (wr == 1) BAR;
            WAIT_V(0); BAR;
        } else {
            STAGE_B(SB(0, 0), bcol, 0); STAGE_A(SA(0, 0), 0, 0);
            STAGE_B(SB(0, 1), bcol + HALF, 0); STAGE_A(SA(0, 1), 1, 0);
            if (wr == 1) BAR;
            WAIT_V(4); BAR;
        }
        STAGE_B(SB(1, 0), bcol, 1); STAGE_A(SA(1, 0), 0, 1); STAGE_B(SB(1, 1), bcol + HALF, 1);
        WAIT_V(6); BAR;
#pragma unroll 1
        for (int t = 0; t < nt - 2; t += 2) {
            if (EPI == EPI_OUT) {
                if (t == (SW / BK)) {
                    const float* rowss = (const float*)(ws + WS_ROWSS);
#pragma unroll
                    for (int ai = 0; ai < 2; ++ai)
#pragma unroll
                        for (int m = 0; m < 4; ++m) {
                            const int row = brow + ai * HALF + wrk * 64 + m * 16 + frk;
                            const float sc = rsqrtf(rowss[row] * (1.0f / SW) + RMS_EPS);
#pragma unroll
                            for (int bj = 0; bj < 2; ++bj)
#pragma unroll
                                for (int n = 0; n < 2; ++n) acc[ai][bj][m][n] *= sc;
                        }
                }
            }
            LDB(B0, 0, 0); SCHED; LDA(At, 0, 0); STAGE_A(SA(1, 1), 1, t + 1);
            WAIT_L(8); BAR; WAIT_L(0); MMA(0, 0, At, B0); BAR; SCHED;
            LDB(B1, 0, 1); STAGE_B(SB(0, 0), bcol, t + 2);
            BAR; WAIT_L(0); MMA(0, 1, At, B1); BAR;
            LDA(At, 0, 1); STAGE_A(SA(0, 0), 0, t + 2);
            BAR; WAIT_L(0); MMA(1, 0, At, B0); BAR; SCHED;
            STAGE_B(SB(0, 1), bcol + HALF, t + 2);
            WAIT_V(6); BAR; MMA(1, 1, At, B1); BAR;
            LDB(B0, 1, 0); SCHED; LDA(At, 1, 0); STAGE_A(SA(0, 1), 1, t + 2);
            WAIT_L(8); BAR; WAIT_L(0); MMA(0, 0, At, B0); BAR; SCHED;
            LDB(B1, 1, 1); STAGE_B(SB(1, 0), bcol, t + 3);
            BAR; WAIT_L(0); MMA(0, 1, At, B1); BAR;
            LDA(At, 1, 1); STAGE_A(SA(1, 0), 0, t + 3);
            BAR; WAIT_L(0); MMA(1, 0, At, B0); BAR; SCHED;
            STAGE_B(SB(1, 1), bcol + HALF, t + 3);
            WAIT_V(6); BAR; MMA(1, 1, At, B1); BAR;
        }
        { LDB(B0, 0, 0); LDA(At, 0, 0); STAGE_A(SA(1, 1), 1, nt - 1);
          BAR; WAIT_L(0); MMA(0, 0, At, B0); BAR;
          LDB(B1, 0, 1); BAR; WAIT_L(0); MMA(0, 1, At, B1); BAR;
          LDA(At, 0, 1); WAIT_V(4); BAR; WAIT_L(0); MMA(1, 0, At, B0); MMA(1, 1, At, B1); BAR; }
        { LDB(B0, 1, 0); LDA(At, 1, 0); WAIT_V(2); BAR; WAIT_L(0); MMA(0, 0, At, B0); BAR;
          LDB(B1, 1, 1); WAIT_V(0); BAR; WAIT_L(0); MMA(0, 1, At, B1); BAR;
          LDA(At, 1, 1); BAR; WAIT_L(0); MMA(1, 0, At, B0); MMA(1, 1, At, B1); BAR; }
        if (wr == 0) BAR;

        const int tide = opaque_tid(), lane = tide & 63, wc = (tide >> 6) & 3, wre = tide >> 8, fr = lane & 15, fq = lane >> 4;
        const int row0 = brow + wre * 64 + fr, col0 = bcol + wc * 32 + 4 * fq;
        if (EPI == EPI_PROJ) {
            const int col0p = bcol + wc * 32 + 8 * fq;
            if (bcol < SW) {
                float* U = (float*)(ws + WS_U);
#pragma unroll
                for (int ai = 0; ai < 2; ++ai)
#pragma unroll
                    for (int m = 0; m < 4; ++m)
#pragma unroll
                        for (int bj = 0; bj < 2; ++bj)
#pragma unroll
                            for (int n = 0; n < 2; ++n)
                                *(f32x4*)(U + (size_t)(row0 + ai * HALF + m * 16) * SW + col0p + bj * HALF + 4 * n) = acc[ai][bj][m][n];
            } else {
                bf16_t* Gb = (bf16_t*)(ws + WS_GBCV);
#pragma unroll
                for (int ai = 0; ai < 2; ++ai)
#pragma unroll
                    for (int m = 0; m < 4; ++m)
#pragma unroll
                        for (int bj = 0; bj < 2; ++bj) {
                            const f32x4 v0 = acc[ai][bj][m][0], v1 = acc[ai][bj][m][1];
                            u32x4 o; o[0] = pk2(v0[0], v0[1]); o[1] = pk2(v0[2], v0[3]); o[2] = pk2(v1[0], v1[1]); o[3] = pk2(v1[2], v1[3]);
                            *(u32x4*)(Gb + (size_t)(row0 + ai * HALF + m * 16) * (3 * CW) + (col0p - SW) + bj * HALF) = o;
                        }
            }
        }
        if (EPI == EPI_GLU) {
            const int col0p = bcol + wc * 32 + 8 * fq;
            const bf16_t* Gg = (const bf16_t*)(ws + WS_G);
            bf16_t* Y = (bf16_t*)(ws + WS_YMIX);
            float* rowss = (float*)(ws + WS_ROWSS);
#pragma unroll
            for (int ai = 0; ai < 2; ++ai)
#pragma unroll
                for (int m = 0; m < 4; ++m) {
                    const int row = row0 + ai * HALF + m * 16;
                    float ss = 0.f;
#pragma unroll
                    for (int bj = 0; bj < 2; ++bj) {
                        const int col = col0p + bj * HALF;
                        const u32x4 gw = *(const u32x4*)(Gg + (size_t)row * SW + col);
                        u32x4 w;
#pragma unroll
                        for (int n = 0; n < 2; ++n) {
                            const f32x4 bz = *(const f32x4*)(P.glu_b + col + 4 * n), gn = *(const f32x4*)(P.nsg + col + 4 * n);
                            const f32x4 gv = (f32x4){bflo(gw[2 * n]), bfhi(gw[2 * n]), bflo(gw[2 * n + 1]), bfhi(gw[2 * n + 1])};
                            f32x4 o;
#pragma unroll
                            for (int j = 0; j < 4; ++j) { o[j] = gv[j] * sigmoidf_(acc[ai][bj][m][n][j] + bz[j]); ss += o[j] * o[j]; o[j] *= gn[j]; }
                            w[2 * n] = pk2(o[0], o[1]); w[2 * n + 1] = pk2(o[2], o[3]);
                        }
                        *(u32x4*)(Y + (size_t)row * D + col) = w;
                    }
                    ss += __shfl_xor(ss, 16); ss += __shfl_xor(ss, 32);
                    if (fq == 0) atomicAdd(rowss + row, ss);
                }
        }
        if (EPI == EPI_OUT || EPI == EPI_DOWN) {
            const float* R = (EPI == EPI_OUT) ? P.x : P.out;
            float* st = (float*)(ws + ((EPI == EPI_OUT) ? WS_ST1 : WS_ST2));
#pragma unroll
            for (int ai = 0; ai < 2; ++ai)
#pragma unroll
                for (int m = 0; m < 4; ++m) {
                    const int row = row0 + ai * HALF + m * 16;
                    float s1 = 0.f, s2 = 0.f;
#pragma unroll
                    for (int bj = 0; bj < 2; ++bj)
#pragma unroll
                        for (int n = 0; n < 2; ++n) {
                            const int col = (EPI == EPI_OUT) ? (bcol + wc * 32 + 8 * fq + bj * HALF + 4 * n) : (col0 + bj * HALF + n * 16);
                            const f32x4 rv = *(const f32x4*)(R + (size_t)row * D + col);
                            f32x4 o;
#pragma unroll
                            for (int j = 0; j < 4; ++j) { o[j] = ALPHA * rv[j] + acc[ai][bj][m][n][j]; s1 += o[j]; s2 += o[j] * o[j]; }
                            if (FUSE) acc[ai][bj][m][n] = o; else *(f32x4*)(P.out + (size_t)row * D + col) = o;
                        }
                    s1 += __shfl_xor(s1, 16); s1 += __shfl_xor(s1, 32);
                    s2 += __shfl_xor(s2, 16); s2 += __shfl_xor(s2, 32);
                    if (fq == 0) { atomicAdd(st + 2 * row, s1); atomicAdd(st + 2 * row + 1, s2); }
                }
            if (FUSE) {
                xcd_barrier(P.ws);
                const int tf = opaque_tid(), lf = tf & 63, r0f = brow + (tf >> 8) * 64 + (lf & 15), c0f = bcol + ((tf >> 6) & 3) * 32 + ((EPI == EPI_OUT) ? 8 : 4) * (lf >> 4);
                const float* gam = (EPI == EPI_OUT) ? P.ln1g : P.ln2g; const float* bet = (EPI == EPI_OUT) ? P.ln1b : P.ln2b;
                bf16_t* HB = (bf16_t*)(ws + WS_H1B);
#pragma unroll
                for (int ai = 0; ai < 2; ++ai)
#pragma unroll
                    for (int m = 0; m < 4; ++m) {
                        const int row = r0f + ai * HALF + m * 16;
                        const float s1 = __hip_atomic_load(st + 2 * row, __ATOMIC_RELAXED, __HIP_MEMORY_SCOPE_AGENT), s2 = __hip_atomic_load(st + 2 * row + 1, __ATOMIC_RELAXED, __HIP_MEMORY_SCOPE_AGENT);
                        const float mean = s1 * (1.0f / D);
                        const float rstd = rsqrtf(fmaxf(s2 * (1.0f / D) - mean * mean, 0.f) + LN_EPS);
#pragma unroll
                        for (int bj = 0; bj < 2; ++bj) {
                            u32x4 wb;
#pragma unroll
                            for (int n = 0; n < 2; ++n) {
                                const int col = c0f + bj * HALF + n * ((EPI == EPI_OUT) ? 4 : 16);
                                const f32x4 gv = *(const f32x4*)(gam + col), bv = *(const f32x4*)(bet + col);
                                f32x4 o;
#pragma unroll
                                for (int j = 0; j < 4; ++j) o[j] = (acc[ai][bj][m][n][j] - mean) * rstd * gv[j] + bv[j];
                                *(f32x4*)(P.out + (size_t)row * D + col) = o;
                                wb[2 * n] = pk2(o[0], o[1]); wb[2 * n + 1] = pk2(o[2], o[3]);
                            }
                            if (EPI == EPI_OUT) *(u32x4*)(HB + (size_t)row * D + c0f + bj * HALF) = wb;
                        }
                    }
            }
        }
        if (EPI == EPI_FFN) {
            f32x4 w0[2], w1[2], w2[2], cb[2];
            const int c0 = pn * 128 + wc * 32 + 8 * fq;
#pragma unroll
            for (int n = 0; n < 2; ++n) {
                const int c = c0 + 4 * n;
                w0[n] = *(const f32x4*)(P.fcw + c); w1[n] = *(const f32x4*)(P.fcw + DFF + c); w2[n] = *(const f32x4*)(P.fcw + 2 * DFF + c); cb[n] = *(const f32x4*)(P.fcb + c);
            }
            pre = false;
            LAS unsigned char* Gs = (LAS unsigned char*)smem + 65536;
            const int ch = 4 * wc + fq;
#pragma unroll
            for (int ai = 0; ai < 2; ++ai)
#pragma unroll
                for (int m = 0; m < 4; ++m) {
                    const int rl = ai * HALF + wre * 64 + m * 16 + fr;
                    f32x4 v0 = acc[ai][0][m][0], v1 = acc[ai][0][m][1];
                    if (brow + rl < 0) { v0 = (f32x4){0.f, 0.f, 0.f, 0.f}; v1 = v0; }
                    u32x4 w; w[0] = pk2(v0[0], v0[1]); w[1] = pk2(v0[2], v0[3]); w[2] = pk2(v1[0], v1[1]); w[3] = pk2(v1[2], v1[3]);
                    *(LAS u32x4*)(Gs + rl * 256 + ((ch ^ (rl & 15)) << 4)) = w;
                }
            __syncthreads();
            bf16_t* ACT = (bf16_t*)(ws + WS_ACT);
#pragma unroll
            for (int ai = 0; ai < 2; ++ai)
#pragma unroll
                for (int m = 0; m < 4; ++m) {
                    const int rl = ai * HALF + wre * 64 + m * 16 + fr, grow = brow + rl;
                    if (rl >= 2 && grow < L) {
                        const u32x4 a1 = *(const LAS u32x4*)(Gs + (rl - 1) * 256 + ((ch ^ ((rl - 1) & 15)) << 4));
                        const u32x4 a2 = *(const LAS u32x4*)(Gs + (rl - 2) * 256 + ((ch ^ ((rl - 2) & 15)) << 4));
                        u32x4 w;
#pragma unroll
                        for (int n = 0; n < 2; ++n) {
                            const f32x4 g1 = (f32x4){bflo(a1[2 * n]), bfhi(a1[2 * n]), bflo(a1[2 * n + 1]), bfhi(a1[2 * n + 1])};
                            const f32x4 g2 = (f32x4){bflo(a2[2 * n]), bfhi(a2[2 * n]), bflo(a2[2 * n + 1]), bfhi(a2[2 * n + 1])};
                            const f32x4 g0 = acc[ai][0][m][n], up = acc[ai][1][m][n];
                            f32x4 o;
                            { const f32x4 a4 = w0[n] * g2 + w1[n] * g1 + w2[n] * g0 + cb[n];
                              f32x4 e4; e4[0] = __expf(-a4[0]); e4[1] = __expf(-a4[1]); e4[2] = __expf(-a4[2]); e4[3] = __expf(-a4[3]);
                              const f32x4 d4 = e4 + 1.0f;
                              f32x4 r4; r4[0] = __builtin_amdgcn_rcpf(d4[0]); r4[1] = __builtin_amdgcn_rcpf(d4[1]); r4[2] = __builtin_amdgcn_rcpf(d4[2]); r4[3] = __builtin_amdgcn_rcpf(d4[3]);
                              o = a4 * r4 * up; }
                            w[2 * n] = pk2(o[0], o[1]); w[2 * n + 1] = pk2(o[2], o[3]);
                        }
                        *(u32x4*)(ACT + (size_t)grow * DFF + c0) = w;
                    }
                }
            __syncthreads();
        }
    }
#undef TILE_OF
#undef FFN_AOFF
#undef STAGE_AX
#undef SA
#undef SB
#undef STAGE_A
#undef STAGE_B
#undef LDA
#undef LDB
#undef MMA
}

using f32x16 = __attribute__((ext_vector_type(16))) float;
typedef short s16x4 __attribute__((ext_vector_type(4)));
#define MFMA32(a, b, c) __builtin_amdgcn_mfma_f32_32x32x16_bf16((a), (b), (c), 0, 0, 0)
__device__ __forceinline__ bf16x8 as_bf16x8(u32x4 v) { return __builtin_bit_cast(bf16x8, v); }
#define CMUL_R(ar, ai, br, bi) ((ar) * (br) - (ai) * (bi))
#define CMUL_I(ar, ai, br, bi) ((ar) * (bi) + (ai) * (br))

template <bool PASSB, bool LOCAL = false>
__device__ __forceinline__ void ssm_phase(const Params& P) {
    unsigned char* ws = P.ws;
    const int tid = opaque_tid(), wid = tid >> 6, lane = tid & 63, pj = lane & 31, hf = lane >> 5;
    LAS unsigned char* xt = (LAS unsigned char*)smem + wid * 9216;
    LAS u32x4* bts = (LAS u32x4*)((LAS unsigned char*)smem + 8 * 9216 + 8192);
    LAS u32x4* cts = (LAS u32x4*)((LAS unsigned char*)smem + 8 * 9216);
    const float* U = (const float*)(ws + WS_U);
    const float2* lamb = (const float2*)(ws + WS_LAMB); const float2* Cin = (const float2*)(ws + WS_CIN); float2* F = (float2*)(ws + WS_F);
    const u32x4* BT = (const u32x4*)(ws + WS_BBAR); const u32x4* CTT = (const u32x4*)(ws + WS_CT);
    bf16_t* Gout = (bf16_t*)(ws + WS_G);
    typedef float f32x2v __attribute__((ext_vector_type(2)));
    LAS f32x2v* Fl = (LAS f32x2v*)((LAS unsigned char*)smem + 8 * 9216 + 16384);
    float2* QT = (float2*)(ws + WS_CIN);
    const float2* l64g = (const float2*)(ws + WS_LAM64);
    for (int it = blockIdx.x; it < NG * 4; it += gridDim.x) {
      const int g = it & 63, cq = it >> 6;
      __syncthreads();
      bts[tid] = BT[(size_t)g * 512 + tid];
      if (PASSB) cts[tid] = CTT[(size_t)g * 512 + tid];
      if (PASSB && LOCAL && wid == 0) {
          const float2 lm = l64g[g * 64 + lane];
          float pr = lm.x, pi_ = lm.y;
#pragma unroll
          for (int k = 0; k < 5; ++k) { const float nr = CMUL_R(pr, pi_, pr, pi_), ni = CMUL_I(pr, pi_, pr, pi_); pr = nr; pi_ = ni; }
          float sr = 0.f, si = 0.f;
          for (int q = 0; q < cq; ++q) { const float2 tq = QT[((size_t)g * 4 + q) * 64 + lane]; const float nr = CMUL_R(pr, pi_, sr, si) + tq.x, ni = CMUL_I(pr, pi_, sr, si) + tq.y; sr = nr; si = ni; }
          float wr_ = sr, wi_ = si;
          for (int ci2 = 0; ci2 < 32; ++ci2) {
              const f32x2v pf = Fl[ci2 * 64 + lane];
              Fl[ci2 * 64 + lane] = (f32x2v){pf.x + wr_, pf.y + wi_};
              const float nr = CMUL_R(lm.x, lm.y, wr_, wi_), ni = CMUL_I(lm.x, lm.y, wr_, wi_); wr_ = nr; wi_ = ni;
          }
      }
      __syncthreads();
      const float2 lA = lamb[g * 64 + pj], lB = lamb[g * 64 + pj + 32];
      float l1[2][2] = {{lA.x, lA.y}, {lB.x, lB.y}}, l2[2][2], l3[2][2], l4[2][2];
#pragma unroll
      for (int sbi = 0; sbi < 2; ++sbi) {
          l2[sbi][0] = CMUL_R(l1[sbi][0], l1[sbi][1], l1[sbi][0], l1[sbi][1]); l2[sbi][1] = CMUL_I(l1[sbi][0], l1[sbi][1], l1[sbi][0], l1[sbi][1]);
          l3[sbi][0] = CMUL_R(l2[sbi][0], l2[sbi][1], l1[sbi][0], l1[sbi][1]); l3[sbi][1] = CMUL_I(l2[sbi][0], l2[sbi][1], l1[sbi][0], l1[sbi][1]);
          l4[sbi][0] = CMUL_R(l2[sbi][0], l2[sbi][1], l2[sbi][0], l2[sbi][1]); l4[sbi][1] = CMUL_I(l2[sbi][0], l2[sbi][1], l2[sbi][0], l2[sbi][1]);
      }
      const int i16 = lane & 15;
      const int traddr = (8 * hf + (i16 >> 2)) * 72 + (16 * ((lane >> 4) & 1) + 4 * (i16 & 3)) * 2;
      if (!PASSB) {
          float l5[2][2], l32[2][2];
#pragma unroll
          for (int sbi = 0; sbi < 2; ++sbi) {
              l5[sbi][0] = CMUL_R(l4[sbi][0], l4[sbi][1], l1[sbi][0], l1[sbi][1]); l5[sbi][1] = CMUL_I(l4[sbi][0], l4[sbi][1], l1[sbi][0], l1[sbi][1]);
              float ar = l4[sbi][0], ai = l4[sbi][1];
#pragma unroll
              for (int k = 0; k < 3; ++k) { const float nr = CMUL_R(ar, ai, ar, ai), ni = CMUL_I(ar, ai, ar, ai); ar = nr; ai = ni; }
              l32[sbi][0] = ar; l32[sbi][1] = ai;
          }
#pragma unroll 1
          for (int kp = 0; kp < 4; kp += 2) {
              float cr2[2][2] = {{0.f, 0.f}, {0.f, 0.f}}, ci2[2][2] = {{0.f, 0.f}, {0.f, 0.f}};
#pragma unroll 1
              for (int tb = 0; tb < 2; ++tb) {
                  f32x16 z2[2][4];
#pragma unroll
                  for (int j = 0; j < 2; ++j) {
                      const int t0 = (cq * 32 + wid + 8 * (kp + j)) * TCH;
                      const float* up = U + (size_t)(t0 + 32 * tb + pj) * SW + g * GH + 8 * hf;
                      const f32x4 u0 = *(const f32x4*)up, u1 = *(const f32x4*)(up + 4);
                      u32x4 hi, lo;
#pragma unroll
                      for (int q = 0; q < 4; ++q) {
                          const float a = (q < 2 ? u0 : u1)[2 * (q & 1)], b = (q < 2 ? u0 : u1)[2 * (q & 1) + 1];
                          hi[q] = pk2(a, b); lo[q] = pk2(a - bflo(hi[q]), b - bfhi(hi[q]));
                      }
                      const bf16x8 uh = as_bf16x8(hi), ul = as_bf16x8(lo);
#pragma unroll
                      for (int kb = 0; kb < 4; ++kb) {
                          const bf16x8 bhk = as_bf16x8(bts[(kb * 2 + 0) * 64 + lane]), blk = as_bf16x8(bts[(kb * 2 + 1) * 64 + lane]);
                          f32x16 acc;
#pragma unroll
                          for (int r = 0; r < 16; ++r) acc[r] = 0.f;
                          acc = MFMA32(uh, bhk, acc); acc = MFMA32(ul, bhk, acc); acc = MFMA32(uh, blk, acc);
                          z2[j][kb] = acc;
                      }
                  }
#pragma unroll
                  for (int j = 0; j < 2; ++j)
#pragma unroll
                      for (int sbi = 0; sbi < 2; ++sbi) {
                          float hr = z2[j][2 * sbi][0], hi_ = z2[j][2 * sbi + 1][0];
#pragma unroll
                          for (int r = 1; r < 16; ++r) {
                              const float fr_ = (r & 3) ? l1[sbi][0] : l5[sbi][0], fi_ = (r & 3) ? l1[sbi][1] : l5[sbi][1];
                              const float nr = CMUL_R(fr_, fi_, hr, hi_) + z2[j][2 * sbi][r], ni = CMUL_I(fr_, fi_, hr, hi_) + z2[j][2 * sbi + 1][r];
                              hr = nr; hi_ = ni;
                          }
                          const float or_ = __shfl_xor(hr, 32), oi_ = __shfl_xor(hi_, 32);
                          const float h0r = hf ? or_ : hr, h0i = hf ? oi_ : hi_, h1r = hf ? hr : or_, h1i = hf ? hi_ : oi_;
                          const float er = CMUL_R(l4[sbi][0], l4[sbi][1], h0r, h0i) + h1r, ei = CMUL_I(l4[sbi][0], l4[sbi][1], h0r, h0i) + h1i;
                          const float c0r = cr2[j][sbi], c0i = ci2[j][sbi];
                          cr2[j][sbi] = CMUL_R(l32[sbi][0], l32[sbi][1], c0r, c0i) + er; ci2[j][sbi] = CMUL_I(l32[sbi][0], l32[sbi][1], c0r, c0i) + ei;
                      }
              }
#pragma unroll
              for (int j = 0; j < 2; ++j) {
                  const int k4j = kp + j, cj = cq * 32 + wid + 8 * k4j;
                  const float2 fv = make_float2(hf ? cr2[j][1] : cr2[j][0], hf ? ci2[j][1] : ci2[j][0]);
                  if (LOCAL) Fl[(wid + 8 * k4j) * 64 + lane] = (f32x2v){fv.x, fv.y}; else F[(size_t)cj * 4096 + g * 64 + lane] = fv;
              }
          }
      } else
      for (int k4 = 0; k4 < 4; ++k4) {
        const int c = cq * 32 + wid + 8 * k4, t0 = c * TCH;
        float cr[2] = {0.f, 0.f}, ci[2] = {0.f, 0.f};
        if (PASSB) {
            float2 cv;
            if (LOCAL) { const f32x2v t2 = Fl[(wid + 8 * k4) * 64 + lane]; cv = make_float2(t2.x, t2.y); } else cv = Cin[(size_t)c * 4096 + g * 64 + lane];
            cr[0] = __shfl(cv.x, pj); ci[0] = __shfl(cv.y, pj); cr[1] = __shfl(cv.x, pj + 32); ci[1] = __shfl(cv.y, pj + 32);
        }
#pragma unroll 1
        for (int tb = 0; tb < 2; ++tb) {
            f32x4 u[2]; bf16x8 uh, ul;
            {
                const float* up = U + (size_t)(t0 + 32 * tb + pj) * SW + g * GH + 8 * hf;
                u[0] = *(const f32x4*)up; u[1] = *(const f32x4*)(up + 4);
                u32x4 hi, lo;
#pragma unroll
                for (int q = 0; q < 4; ++q) {
                    const float a = u[q >> 1][2 * (q & 1)], b = u[q >> 1][2 * (q & 1) + 1];
                    hi[q] = pk2(a, b); lo[q] = pk2(a - bflo(hi[q]), b - bfhi(hi[q]));
                }
                uh = as_bf16x8(hi); ul = as_bf16x8(lo);
            }
            f32x16 z[4];
#pragma unroll
            for (int kb = 0; kb < 4; ++kb) {
                const bf16x8 bhk = as_bf16x8(bts[(kb * 2 + 0) * 64 + lane]), blk = as_bf16x8(bts[(kb * 2 + 1) * 64 + lane]);
                f32x16 acc;
#pragma unroll
                for (int r = 0; r < 16; ++r) acc[r] = 0.f;
                acc = MFMA32(uh, bhk, acc); acc = MFMA32(ul, bhk, acc); acc = MFMA32(uh, blk, acc);
                z[kb] = acc;
            }
#pragma unroll
            for (int sbi = 0; sbi < 2; ++sbi)
#pragma unroll
                for (int q = 0; q < 4; ++q)
#pragma unroll
                    for (int sx = 1; sx < 4; ++sx) {
                        const int r = 4 * q + sx;
                        const float xr = z[2 * sbi][r - 1], xi = z[2 * sbi + 1][r - 1];
                        z[2 * sbi][r] += CMUL_R(l1[sbi][0], l1[sbi][1], xr, xi);
                        z[2 * sbi + 1][r] += CMUL_I(l1[sbi][0], l1[sbi][1], xr, xi);
                    }
#pragma unroll
            for (int q = 0; q < 4; ++q)
#pragma unroll
                for (int sbi = 0; sbi < 2; ++sbi) {
                    const float owr = z[2 * sbi][4 * q + 3], owi = z[2 * sbi + 1][4 * q + 3];
                    const float otr = __shfl_xor(owr, 32), oti = __shfl_xor(owi, 32);
                    const float ear = hf ? otr : owr, eai = hf ? oti : owi, ebr = hf ? owr : otr, ebi = hf ? owi : oti;
                    const float c0r = cr[sbi], c0i = ci[sbi];
                    const float c1r = CMUL_R(l4[sbi][0], l4[sbi][1], c0r, c0i) + ear, c1i = CMUL_I(l4[sbi][0], l4[sbi][1], c0r, c0i) + eai;
                    const float c2r = CMUL_R(l4[sbi][0], l4[sbi][1], c1r, c1i) + ebr, c2i = CMUL_I(l4[sbi][0], l4[sbi][1], c1r, c1i) + ebi;
                    if (PASSB) {
                        const float mr = hf ? c1r : c0r, mi = hf ? c1i : c0i;
                        z[2 * sbi][4 * q + 0] += CMUL_R(l1[sbi][0], l1[sbi][1], mr, mi); z[2 * sbi + 1][4 * q + 0] += CMUL_I(l1[sbi][0], l1[sbi][1], mr, mi);
                        z[2 * sbi][4 * q + 1] += CMUL_R(l2[sbi][0], l2[sbi][1], mr, mi); z[2 * sbi + 1][4 * q + 1] += CMUL_I(l2[sbi][0], l2[sbi][1], mr, mi);
                        z[2 * sbi][4 * q + 2] += CMUL_R(l3[sbi][0], l3[sbi][1], mr, mi); z[2 * sbi + 1][4 * q + 2] += CMUL_I(l3[sbi][0], l3[sbi][1], mr, mi);
                        z[2 * sbi][4 * q + 3] += CMUL_R(l4[sbi][0], l4[sbi][1], mr, mi); z[2 * sbi + 1][4 * q + 3] += CMUL_I(l4[sbi][0], l4[sbi][1], mr, mi);
                    }
                    cr[sbi] = c2r; ci[sbi] = c2i;
                }
            if (PASSB) {
#pragma unroll
                for (int kb = 0; kb < 4; ++kb)
#pragma unroll
                    for (int q = 0; q < 4; ++q) {
                        u32x2 w; w[0] = pk2(z[kb][4 * q], z[kb][4 * q + 1]); w[1] = pk2(z[kb][4 * q + 2], z[kb][4 * q + 3]);
                        *(LAS u32x2*)(xt + (32 * kb + pj) * 72 + (8 * q + 4 * hf) * 2) = w;
                    }
                f32x16 y;
#pragma unroll
                for (int r = 0; r < 16; ++r) y[r] = 0.f;
#pragma unroll 2
                for (int kk = 0; kk < 8; ++kk) {
                    const bf16x8 af = as_bf16x8(cts[kk * 64 + lane]);
                    const s16x4 b0 = __builtin_amdgcn_ds_read_tr16_b64_v4i16((LAS s16x4*)(xt + traddr + (16 * kk) * 72));
                    const s16x4 b1 = __builtin_amdgcn_ds_read_tr16_b64_v4i16((LAS s16x4*)(xt + traddr + (16 * kk + 4) * 72));
                    bf16x8 bf; bf[0] = b0[0]; bf[1] = b0[1]; bf[2] = b0[2]; bf[3] = b0[3]; bf[4] = b1[0]; bf[5] = b1[1]; bf[6] = b1[2]; bf[7] = b1[3];
                    y = MFMA32(af, bf, y);
                }
                const f32x4 dv0 = *(const f32x4*)(P.ssm_d + g * GH + 8 * hf), dv1 = *(const f32x4*)(P.ssm_d + g * GH + 8 * hf + 4);
                float o[8];
#pragma unroll
                for (int q = 0; q < 2; ++q)
#pragma unroll
                    for (int sx = 0; sx < 4; ++sx) {
                        const float yv = y[4 * q + sx] + y[4 * (q + 2) + sx] + (q ? dv1[sx] : dv0[sx]) * u[q][sx];
                        o[4 * q + sx] = gelu_tanh(yv);
                    }
                u32x4 w; w[0] = pk2(o[0], o[1]); w[1] = pk2(o[2], o[3]); w[2] = pk2(o[4], o[5]); w[3] = pk2(o[6], o[7]);
                *(u32x4*)(Gout + (size_t)(t0 + 32 * tb + pj) * SW + g * GH + 8 * hf) = w;
            }
        }
        if (!PASSB) {
            const float2 fv = make_float2(hf ? cr[1] : cr[0], hf ? ci[1] : ci[0]);
            if (LOCAL) Fl[(wid + 8 * k4) * 64 + lane] = (f32x2v){fv.x, fv.y}; else F[(size_t)c * 4096 + g * 64 + lane] = fv;
        }
      }
      if (!PASSB && LOCAL) {
          __syncthreads();
          if (wid == 0) {
              const float2 lm = l64g[g * 64 + lane];
              float xr = 0.f, xi = 0.f;
              for (int ci2 = 0; ci2 < 32; ++ci2) {
                  const f32x2v f = Fl[ci2 * 64 + lane];
                  Fl[ci2 * 64 + lane] = (f32x2v){xr, xi};
                  const float nr = CMUL_R(lm.x, lm.y, xr, xi) + f.x, ni = CMUL_I(lm.x, lm.y, xr, xi) + f.y; xr = nr; xi = ni;
              }
              QT[((size_t)g * 4 + cq) * 64 + lane] = make_float2(xr, xi);
          }
      }
    }
}

__device__ __forceinline__ void carry_phase(const Params& P) {
    unsigned char* ws = P.ws;
    const int tid = opaque_tid();
    if (tid >= 64) return;
    const float2* F = (const float2*)(ws + WS_F); float2* Cin = (float2*)(ws + WS_CIN); const float2* l64 = (const float2*)(ws + WS_LAM64);
    const int per = (NG * NP + (int)gridDim.x - 1) / (int)gridDim.x;
    for (int k0 = 0; k0 < per; k0 += 64) {
        const int li = k0 + tid, gp = blockIdx.x * per + li;
        if (li >= per || gp >= NG * NP) continue;
        const float2 lm = l64[gp];
        float xr = 0.f, xi = 0.f;
#pragma unroll 1
        for (int c0 = 0; c0 < NCH; c0 += 32) {
            float2 f[32];
#pragma unroll
            for (int k = 0; k < 32; ++k) f[k] = F[(size_t)(c0 + k) * 4096 + gp];
#pragma unroll
            for (int k = 0; k < 32; ++k) {
                Cin[(size_t)(c0 + k) * 4096 + gp] = make_float2(xr, xi);
                const float nr = lm.x * xr - lm.y * xi + f[k].x, ni = lm.x * xi + lm.y * xr + f[k].y;
                xr = nr; xi = ni;
            }
        }
    }
}

__device__ __forceinline__ void sconv_load(const bf16_t* Gb, int t, int lane, u32x4 (&r)[6]) {
    const bf16_t* row = Gb + (size_t)t * (3 * CW) + 8 * lane;
#pragma unroll
    for (int i = 0; i < 2; ++i) { r[3 * i] = *(const u32x4*)(row + 512 * i); r[3 * i + 1] = *(const u32x4*)(row + CW + 512 * i); r[3 * i + 2] = *(const u32x4*)(row + 2 * CW + 512 * i); }
}
__device__ __forceinline__ void sconv_prod(const u32x4 (&r)[6], float (&p)[16]) {
#pragma unroll
    for (int i = 0; i < 2; ++i)
#pragma unroll
        for (int q = 0; q < 4; ++q) { p[8 * i + 2 * q] = bflo(r[3 * i + 1][q]) * bflo(r[3 * i + 2][q]); p[8 * i + 2 * q + 1] = bfhi(r[3 * i + 1][q]) * bfhi(r[3 * i + 2][q]); }
}
template <bool ALLW = false>
__device__ __forceinline__ void sconv_phase(const Params& P, int b0, int nbk) {
    unsigned char* ws = P.ws;
    if ((int)blockIdx.x < b0) return;
    const int tid = opaque_tid(), wid = tid >> 6, lane = tid & 63;
    const bf16_t* Gb = (const bf16_t*)(ws + WS_GBCV);
    bf16_t* Y = (bf16_t*)(ws + WS_YMIX);
    if (!ALLW && wid == 0) return;
    const int NWV = ALLW ? 8 : 7, W = nbk * NWV, w = ((int)blockIdx.x - b0) * NWV + (ALLW ? wid : wid - 1), R = (L + W - 1) / W, tb = w * R, te = (tb + R < L) ? tb + R : L;
    if (tb >= te) return;
    float w0[16], w1[16], w2[16], gn[16];
#pragma unroll
    for (int i = 0; i < 2; ++i)
#pragma unroll
        for (int q = 0; q < 2; ++q) {
            const int c = 8 * lane + 512 * i + 4 * q;
            const f32x4 a = *(const f32x4*)(P.sconv_w + c), b = *(const f32x4*)(P.sconv_w + CW + c), d = *(const f32x4*)(P.sconv_w + 2 * CW + c), g = *(const f32x4*)(P.ncg + c);
#pragma unroll
            for (int j = 0; j < 4; ++j) { w0[8 * i + 4 * q + j] = a[j]; w1[8 * i + 4 * q + j] = b[j]; w2[8 * i + 4 * q + j] = d[j]; gn[8 * i + 4 * q + j] = g[j]; }
        }
    float p2[16], p1[16];
    u32x4 r[6];
#pragma unroll
    for (int k = 0; k < 16; ++k) { p2[k] = 0.f; p1[k] = 0.f; }
    if (tb >= 2) { sconv_load(Gb, tb - 2, lane, r); sconv_prod(r, p2); }
    if (tb >= 1) { sconv_load(Gb, tb - 1, lane, r); sconv_prod(r, p1); }
    sconv_load(Gb, tb, lane, r);
    for (int t = tb; t < te; ++t) {
        u32x4 rn[6];
        const int tn = (t + 1 < te) ? t + 1 : t;
        sconv_load(Gb, tn, lane, rn);
        float p0[16], y[16]; float ss = 0.f;
        sconv_prod(r, p0);
#pragma unroll
        for (int i = 0; i < 2; ++i)
#pragma unroll
            for (int q = 0; q < 4; ++q) {
                const int k = 8 * i + 2 * q;
                y[k] = bflo(r[3 * i][q]) * (w0[k] * p2[k] + w1[k] * p1[k] + w2[k] * p0[k]);
                y[k + 1] = bfhi(r[3 * i][q]) * (w0[k + 1] * p2[k + 1] + w1[k + 1] * p1[k + 1] + w2[k + 1] * p0[k + 1]);
                ss += y[k] * y[k] + y[k + 1] * y[k + 1];
            }
#pragma unroll
        for (int o = 1; o < 64; o <<= 1) ss += __shfl_xor(ss, o);
        const float sc = rsqrtf(ss * (1.0f / CW) + RMS_EPS);
#pragma unroll
        for (int i = 0; i < 2; ++i) {
            u32x4 o;
#pragma unroll
            for (int q = 0; q < 4; ++q) o[q] = pk2(y[8 * i + 2 * q] * sc * gn[8 * i + 2 * q], y[8 * i + 2 * q + 1] * sc * gn[8 * i + 2 * q + 1]);
            *(u32x4*)(Y + (size_t)t * D + CW + 8 * lane + 512 * i) = o;
        }
#pragma unroll
        for (int k = 0; k < 16; ++k) { p2[k] = p1[k]; p1[k] = p0[k]; }
#pragma unroll
        for (int k = 0; k < 6; ++k) r[k] = rn[k];
    }
}

__device__ __forceinline__ void glu_sconv_phase(const Params& P) {
    unsigned char* ws = P.ws;
    gemm_phase<SW, EPI_GLU>(P, (const bf16_t*)(ws + WS_G), (const bf16_t*)(ws + WS_WGLU), L / BM, SW / BM);
    constexpr int S0 = S_IN + S_GLU + S_OUT + S_GU_EARLY;
    __syncthreads();
    convert_strips(P, S0, S_EARLY, 1, (unsigned*)(ws + WS_BAR) + XCD_BAR_WORDS);
}

__device__ __forceinline__ void ffn_phase(const Params& P) {
    unsigned char* ws = P.ws;
    constexpr int NM = 33, NN = 2 * DFF / BM;
    gemm_phase<D, EPI_FFN>(P, (const bf16_t*)(ws + WS_H1B), (const bf16_t*)(ws + WS_WGU), NM, NN);
    const int G = gridDim.x, rem = (NM * NN) % G, b = blockIdx.x;
    __syncthreads();
    if (rem == 0) convert_strips(P, S_EARLY + b, S_EARLY + S_D, G);
    else if (b >= rem) convert_strips(P, S_EARLY + (b - rem), S_EARLY + S_D, G - rem);
}

template <bool FIRST>
__device__ __forceinline__ void ln_phase(const Params& P) {
    unsigned char* ws = P.ws;
    const int tid = opaque_tid(), wid = tid >> 6, lane = tid & 63;
    const float* st = (const float*)(ws + (FIRST ? WS_ST1 : WS_ST2));
    const float* gam = FIRST ? P.ln1g : P.ln2g; const float* bet = FIRST ? P.ln1b : P.ln2b;
    bf16_t* HB = (bf16_t*)(ws + WS_H1B);
    for (int t = blockIdx.x * 8 + wid; t < L; t += gridDim.x * 8) {
        const float mean = st[2 * t] * (1.0f / D);
        const float var = fmaxf(st[2 * t + 1] * (1.0f / D) - mean * mean, 0.f);
        const float rstd = rsqrtf(var + LN_EPS);
        float* row = P.out + (size_t)t * D;
#pragma unroll
        for (int i = 0; i < 4; ++i) {
            const int c = 8 * lane + 512 * i;
            const f32x4 a = *(const f32x4*)(row + c), b = *(const f32x4*)(row + c + 4);
            const f32x4 g0 = *(const f32x4*)(gam + c), g1 = *(const f32x4*)(gam + c + 4), b0 = *(const f32x4*)(bet + c), b1 = *(const f32x4*)(bet + c + 4);
            f32x4 o0, o1;
#pragma unroll
            for (int j = 0; j < 4; ++j) { o0[j] = (a[j] - mean) * rstd * g0[j] + b0[j]; o1[j] = (b[j] - mean) * rstd * g1[j] + b1[j]; }
            *(f32x4*)(row + c) = o0; *(f32x4*)(row + c + 4) = o1;
            if (FIRST) { u32x4 o; o[0] = pk2(o0[0], o0[1]); o[1] = pk2(o0[2], o0[3]); o[2] = pk2(o1[0], o1[1]); o[3] = pk2(o1[2], o1[3]); *(u32x4*)(HB + (size_t)t * D + c) = o; }
        }
    }
}


#define XB_SPIN_CAP (1u << 22)
__device__ __forceinline__ unsigned xb_ld(unsigned* p)              { return __hip_atomic_load(p, __ATOMIC_RELAXED, __HIP_MEMORY_SCOPE_AGENT); }
__device__ __forceinline__ unsigned xb_add(unsigned* p, unsigned v) { return __hip_atomic_fetch_add(p, v, __ATOMIC_RELAXED, __HIP_MEMORY_SCOPE_AGENT); }
__device__ __forceinline__ unsigned xb_xcc_id() { return (unsigned)__builtin_amdgcn_s_getreg((3 << 11) | 20) & 0xFu; }
#define XB_SPIN(cond, bar) do { unsigned _sp = 0; while (cond) { __builtin_amdgcn_s_sleep(1); \
    if ((++_sp & 255u) == 0u) { if (xb_ld(&(bar)[XB_TMO])) break; if (_sp > XB_SPIN_CAP) { atomicAdd(&(bar)[XB_TMO], 1u); break; } } } } while (0)
struct XcdBarrier { unsigned* bar; unsigned x; volatile LAS unsigned* st; };
__device__ __forceinline__ XcdBarrier xcd_barrier_post(unsigned* bar, volatile LAS unsigned* st) {
    XcdBarrier b; b.bar = bar; b.x = xb_xcc_id(); b.st = st;
    if (threadIdx.x == 0) (void)xb_add(&bar[XB_XCNT(b.x)], 1u);
    return b;
}
__device__ __forceinline__ void xcd_barrier_complete(unsigned* bar, unsigned x, unsigned& nloc, unsigned& nx) {
    const unsigned G = gridDim.x * gridDim.y * gridDim.z;
    unsigned sum, cnt, mine, sp = 0u;
    for (;;) {
        sum = 0u; cnt = 0u; mine = 0u;
#pragma unroll
        for (unsigned j = 0; j < 16; ++j) { const unsigned c = xb_ld(&bar[XB_XCNT(j)]); sum += c; cnt += (c > 0u) ? 1u : 0u; mine = (j == x) ? c : mine; }
        if (sum == G) break;
        __builtin_amdgcn_s_sleep(1);
        if ((++sp & 255u) == 0u) { if (xb_ld(&bar[XB_TMO])) break; if (sp > XB_SPIN_CAP) { atomicAdd(&bar[XB_TMO], 1u); break; } }
    }
    nloc = mine > 0u ? mine : 1u; nx = cnt > 0u ? cnt : 1u;
}
__device__ __forceinline__ void xcd_barrier(unsigned char* wsb) {
    asm volatile("s_waitcnt vmcnt(0)" ::: "memory");
    __syncthreads();
    if (threadIdx.x == 0) {
        XcdBarrier b; b.bar = (unsigned*)(wsb + WS_BAR); b.x = xb_xcc_id(); b.st = (volatile LAS unsigned*)(LAS unsigned char*)(smem + 128 * 1024);
        unsigned* bar = b.bar;
        __builtin_amdgcn_s_waitcnt(0);
        unsigned nloc = b.st[0], nx = b.st[1];
        if (nloc == 0u) { xcd_barrier_complete(bar, b.x, nloc, nx); b.st[0] = nloc; b.st[1] = nx; }
        const unsigned old = xb_add(&bar[XB_XSUB(b.x)], 1u);
        const unsigned gen = old / nloc;
        if (old + 1u == (gen + 1u) * nloc) {
            __builtin_amdgcn_fence(__ATOMIC_RELEASE, "agent");
            asm volatile("s_waitcnt vmcnt(0)" ::: "memory");
            const unsigned og = xb_add(&bar[XB_TOP], 1u);
            const unsigned tg = og / nx;
            if (og + 1u == (tg + 1u) * nx) xb_add(&bar[XB_TOPGEN], 1u);
            else XB_SPIN(xb_ld(&bar[XB_TOPGEN]) == tg, bar);
            __builtin_amdgcn_fence(__ATOMIC_ACQUIRE, "agent");
            xb_add(&bar[XB_XGEN(b.x)], 1u);
            asm volatile("s_waitcnt vmcnt(0)" ::: "memory");
        } else {
            XB_SPIN(xb_ld(&bar[XB_XGEN(b.x)]) == gen, bar);
            __builtin_amdgcn_fence(__ATOMIC_ACQUIRE, "agent");
            asm volatile("s_waitcnt vmcnt(0)" ::: "memory");
        }
    }
    __syncthreads();
}

template <bool COOP, bool FUSELN>
__global__ void __launch_bounds__(512) fwd_kernel(Params P, int ph_lo, int ph_hi) {
    unsigned char* ws = P.ws;
#ifndef PHMASK
#define PHMASK 0x7ff
#endif
#define RUN_PHASE(k, body) do { if ((PHMASK & (1 << k)) && (COOP || (ph_lo <= k && k < ph_hi))) { body; } if (COOP && k < 10) xcd_barrier(P.ws); } while (0)
    if (COOP) {
        unsigned* bar = (unsigned*)(ws + WS_BAR);
        volatile LAS unsigned* st = (volatile LAS unsigned*)(LAS unsigned char*)(smem + 128 * 1024);
        if (threadIdx.x == 0) { st[0] = 0u; st[1] = 0u; }
        __syncthreads();
        (void)xcd_barrier_post(bar, st);
        if (ph_hi > 1000) cg::this_grid().sync();
        phase0(P);
        xcd_barrier(P.ws);
    } else {
        if (ph_lo == 0) phase0(P);
    }
    RUN_PHASE(1, (gemm_phase<D, EPI_PROJ>(P, (const bf16_t*)(ws + WS_XB), (const bf16_t*)(ws + WS_WIN), L / BM, DIN / BM)));
    if (COOP && FUSELN) {
        ssm_phase<false, true>(P);
        xcd_barrier(P.ws);
        ssm_phase<true, true>(P);
        sconv_phase<true>(P, 0, gridDim.x);
        xcd_barrier(P.ws);
    } else {
        RUN_PHASE(2, ssm_phase<false>(P));
        RUN_PHASE(3, carry_phase(P); sconv_phase(P, 0, gridDim.x));
        RUN_PHASE(4, ssm_phase<true>(P));
    }
    RUN_PHASE(5, (glu_sconv_phase(P)));
    if (COOP && FUSELN) {
        gemm_phase<D, EPI_OUT, true>(P, (const bf16_t*)(ws + WS_YMIX), (const bf16_t*)(ws + WS_WOUT), L / BM, D / BM);
        xcd_barrier(P.ws);
    } else {
        RUN_PHASE(6, (gemm_phase<D, EPI_OUT>(P, (const bf16_t*)(ws + WS_YMIX), (const bf16_t*)(ws + WS_WOUT), L / BM, D / BM)));
        RUN_PHASE(7, ln_phase<true>(P));
    }
    RUN_PHASE(8, ffn_phase(P));
    if (COOP && FUSELN) {
        gemm_phase<DFF, EPI_DOWN, true>(P, (const bf16_t*)(ws + WS_ACT), (const bf16_t*)(ws + WS_WD), L / BM, D / BM);
    } else {
        RUN_PHASE(9, (gemm_phase<DFF, EPI_DOWN>(P, (const bf16_t*)(ws + WS_ACT), (const bf16_t*)(ws + WS_WD), L / BM, D / BM)));
        RUN_PHASE(10, ln_phase<false>(P));
    }
}

constexpr int LDS_BYTES = 128 * 1024 + 64;

extern "C" void kernel_launch(void* const* d_in, const int* in_sizes, int n_in, void* d_out, int out_size, void* d_ws, size_t ws_size, hipStream_t stream) {
    static int grid = 0;
    if (grid == 0) {
        int dev = 0, cus = 0, per_cu = 0;
        hipGetDevice(&dev);
        hipDeviceGetAttribute(&cus, hipDeviceAttributeMultiprocessorCount, dev);
        hipFuncSetAttribute((const void*)fwd_kernel<true, true>, hipFuncAttributeMaxDynamicSharedMemorySize, LDS_BYTES);
        hipFuncSetAttribute((const void*)fwd_kernel<true, false>, hipFuncAttributeMaxDynamicSharedMemorySize, LDS_BYTES);
        hipFuncSetAttribute((const void*)fwd_kernel<false, false>, hipFuncAttributeMaxDynamicSharedMemorySize, LDS_BYTES);
        hipOccupancyMaxActiveBlocksPerMultiprocessor(&per_cu, (const void*)fwd_kernel<true, true>, 512, LDS_BYTES);
        if (per_cu < 1) per_cu = 1;
        grid = cus * per_cu;
        if (n_in != 25 || ws_size < 256 * MiB) fprintf(stderr, "kernel_launch: unexpected n_in %d / ws_size %zu\n", n_in, ws_size);
        (void)hipGetLastError();
    }
    Params p{};
    const float** pp = (const float**)&p;
    for (int i = 0; i < 25; ++i) pp[i] = (const float*)d_in[i];
    p.out = (float*)d_out; p.ws = (unsigned char*)d_ws;
    (void)hipMemsetAsync((unsigned char*)d_ws + WS_BAR, 0, XCD_BAR_WORDS * 4 + 256, stream);
#if N_LAUNCH == 1
    int lo = 0, hi = 11;
    void* args[] = {&p, &lo, &hi};
    const bool fuse = (grid == (L / BM) * (D / BM));
    hipError_t e = hipLaunchCooperativeKernel(fuse ? (const void*)fwd_kernel<true, true> : (const void*)fwd_kernel<true, false>, dim3(grid), dim3(512), args, LDS_BYTES, stream);
    if (e != hipSuccess) fprintf(stderr, "cooperative launch failed: %s (grid %d)\n", hipGetErrorString(e), grid);
#else
    for (int ph = 0; ph < 11; ++ph) hipLaunchKernelGGL(fwd_kernel<false, false>, dim3(grid), dim3(512), LDS_BYTES, stream, p, ph, ph + 1);
#endif
}
```

```cpp
#include <hip/hip_runtime.h>
#include <hip/hip_cooperative_groups.h>
#include <cstdio>
#include <cstdint>
namespace cg = cooperative_groups;

#ifndef PREISSUE
#define PREISSUE 0
#endif
#ifndef N_LAUNCH
#define N_LAUNCH 1
#endif

typedef unsigned short bf16_t;
using bf16x8 = __attribute__((ext_vector_type(8))) short;
using f32x4 = __attribute__((ext_vector_type(4))) float;
using u32x4 = __attribute__((ext_vector_type(4))) unsigned;
using u32x2 = __attribute__((ext_vector_type(2))) unsigned;

constexpr int L = 8192, D = 2048, DIN = 4096, SW = 1024, CW = 1024, NG = 64, GH = 16, NP = 64, DFF = 5632;
constexpr int TCH = 64, NCH = L / TCH;
constexpr float ALPHA = 1.189207115002721f;
constexpr float LN_EPS = 1e-5f, RMS_EPS = 1e-6f;

constexpr size_t MiB = 1024 * 1024;
constexpr size_t WS_WIN = 0, WS_WGLU = 16 * MiB, WS_WOUT = 18 * MiB, WS_WGU = 26 * MiB, WS_WD = 70 * MiB;
constexpr size_t WS_XB = 92 * MiB, WS_YMIX = 92 * MiB;
constexpr size_t WS_U = 124 * MiB, WS_H1B = 124 * MiB;
constexpr size_t WS_GBCV = 156 * MiB, WS_ACT = 156 * MiB;
constexpr size_t WS_G = 204 * MiB;
constexpr size_t WS_F = 244 * MiB, WS_LTP = 248 * MiB, WS_BBAR = 252 * MiB, WS_CT = 252 * MiB + 512 * 1024;
constexpr size_t WS_LAMB = 253 * MiB, WS_LAM64 = 253 * MiB + 64 * 1024, WS_CIN = 248 * MiB, WS_ROWSS = 253 * MiB + 256 * 1024, WS_ST1 = WS_ROWSS + 32 * 1024, WS_ST2 = WS_ST1 + 64 * 1024, WS_BAR = WS_ROWSS + 256 * 1024;

struct Params {
    const float *x, *w_in, *lam_re, *lam_im, *log_dt, *b_re, *b_im, *c_re, *c_im, *ssm_d, *glu_w, *glu_b, *sconv_w, *nsg, *ncg,
        *w_out, *ln1g, *ln1b, *wg, *wu, *fcw, *fcb, *wd, *ln2g, *ln2b;
    float* out;
    unsigned char* ws;
};

extern __shared__ __attribute__((aligned(16))) unsigned char smem[];

#define LAS __attribute__((address_space(3)))
#define XB_TMO      128
#define XB_XCNT(j)  (256  + 64 * (j))
#define XB_XSUB(j)  (1280 + 64 * (j))
#define XB_XGEN(j)  (2304 + 64 * (j))
#define XB_TOP      3328
#define XB_TOPGEN   3392
#define XCD_BAR_WORDS 3456
__device__ __forceinline__ int opaque_tid() { int t = threadIdx.x; asm volatile("" : "+v"(t)); return t; }
__device__ __forceinline__ unsigned pk2(float lo, float hi) { unsigned r; asm volatile("v_cvt_pk_bf16_f32 %0, %1, %2" : "=v"(r) : "v"(lo), "v"(hi)); return r; }
__device__ __forceinline__ float bflo(unsigned w) { return __uint_as_float(w << 16); }
__device__ __forceinline__ float bfhi(unsigned w) { return __uint_as_float(w & 0xffff0000u); }
__device__ __forceinline__ float sigmoidf_(float z) { return __builtin_amdgcn_rcpf(1.0f + __expf(-z)); }
__device__ __forceinline__ float gelu_tanh(float y) { float z = 0.7978845608028654f * (y + 0.044715f * y * y * y); return y * sigmoidf_(2.0f * z); }

__device__ __forceinline__ void dsincos(double th, double& s, double& c) {
    const double TWO_PI_HI = 6.283185307179586, TWO_PI_LO = 2.4492935982947064e-16;
    double n = rint(th * 0.15915494309189535);
    double r = fma(-n, TWO_PI_HI, th); r = fma(-n, TWO_PI_LO, r);
    double q = rint(r * 0.6366197723675814);
    double t = fma(-q, 1.5707963267948966, r); t = fma(-q, 6.123233995736766e-17, t);
    double t2 = t * t;
    double sp = t * (1.0 + t2 * (-1.0 / 6 + t2 * (1.0 / 120 + t2 * (-1.0 / 5040 + t2 * (1.0 / 362880 + t2 * (-1.0 / 39916800 + t2 * (1.0 / 6227020800.0)))))));
    double cp = 1.0 + t2 * (-0.5 + t2 * (1.0 / 24 + t2 * (-1.0 / 720 + t2 * (1.0 / 40320 + t2 * (-1.0 / 3628800 + t2 * (1.0 / 479001600.0 + t2 * (-1.0 / 87178291200.0)))))));
    int qi = ((int)q) & 3;
    s = (qi == 0) ? sp : (qi == 1) ? cp : (qi == 2) ? -sp : -cp;
    c = (qi == 0) ? cp : (qi == 1) ? -sp : (qi == 2) ? -cp : sp;
}
__device__ __forceinline__ double dexp(double x) {
    if (x < -700.0) return 0.0;
    double k = rint(x * 1.4426950408889634);
    double r = fma(-k, 0.6931471805599453, x); r = fma(-k, 2.3190468138462996e-17, r);
    double p = 1.0 + r * (1.0 + r * (0.5 + r * (1.0 / 6 + r * (1.0 / 24 + r * (1.0 / 120 + r * (1.0 / 720 + r * (1.0 / 5040 + r * (1.0 / 40320 + r * (1.0 / 362880 + r * (1.0 / 3628800 + r * (1.0 / 39916800 + r * (1.0 / 479001600.0))))))))))));
    long long bits = ((long long)((int)k + 1023)) << 52;
    return p * __longlong_as_double(bits);
}

struct Strip { const float* W; bf16_t* WT; int K, N, mode, k0, n0; };
constexpr int S_IN = (D / 64) * (DIN / 256), S_GLU = (SW / 64) * (SW / 256), S_OUT = (D / 64) * (D / 256), S_G = (D / 64) * (DFF / 256), S_D = (DFF / 64) * (D / 256);
constexpr int S_EARLY = S_IN + S_GLU + S_OUT + 2 * S_G;
constexpr int S_GU_EARLY = 0;
__device__ __forceinline__ Strip strip_desc(const Params& P, int sidx) {
    unsigned char* ws = P.ws;
    Strip t; int r = sidx;
    if (r < S_IN) { t.W = P.w_in; t.WT = (bf16_t*)(ws + WS_WIN); t.K = D; t.N = DIN; t.mode = 0; }
    else if ((r -= S_IN) < S_GLU) { t.W = P.glu_w; t.WT = (bf16_t*)(ws + WS_WGLU); t.K = SW; t.N = SW; t.mode = 0; }
    else if ((r -= S_GLU) < S_OUT) { t.W = P.w_out; t.WT = (bf16_t*)(ws + WS_WOUT); t.K = D; t.N = D; t.mode = 0; }
    else if ((r -= S_OUT) < S_G) { t.W = P.wg; t.WT = (bf16_t*)(ws + WS_WGU); t.K = D; t.N = DFF; t.mode = 1; }
    else if ((r -= S_G) < S_G) { t.W = P.wu; t.WT = (bf16_t*)(ws + WS_WGU); t.K = D; t.N = DFF; t.mode = 2; }
    else { r -= S_G; t.W = P.wd; t.WT = (bf16_t*)(ws + WS_WD); t.K = DFF; t.N = D; t.mode = 0; }
    const int nk = t.K / 64;
    t.k0 = (r % nk) * 64; t.n0 = (r / nk) * 256;
    return t;
}
__device__ __forceinline__ void strip_load(const Strip& t, int tid, f32x4 (&v)[8]) {
    const float* src = t.W + (size_t)(t.k0 + (tid >> 6)) * t.N + t.n0 + 4 * (tid & 63);
#pragma unroll
    for (int i = 0; i < 8; ++i) v[i] = __builtin_nontemporal_load((const f32x4*)(src + (size_t)(8 * i) * t.N));
}
__device__ __forceinline__ void strip_lds_write(float* tile, int tid, const f32x4 (&v)[8]) {
#pragma unroll
    for (int i = 0; i < 8; ++i) *(f32x4*)(tile + ((tid >> 6) + 8 * i) * 256 + ((4 * (tid & 63)) ^ (i << 3))) = v[i];
}
__device__ __forceinline__ void strip_store(const float* tile, int tid, const Strip& cur) {
    const int kc = tid & 7;
#pragma unroll
    for (int j = 0; j < 4; ++j) {
        const int n = 64 * j + (tid >> 3);
        const float* q = tile + (8 * kc) * 256 + (n ^ (kc << 3));
        u32x4 o;
        o[0] = pk2(q[0 * 256], q[1 * 256]); o[1] = pk2(q[2 * 256], q[3 * 256]); o[2] = pk2(q[4 * 256], q[5 * 256]); o[3] = pk2(q[6 * 256], q[7 * 256]);
        const int nn = cur.n0 + n;
        int drow = nn;
        if (cur.mode == 1) drow = 256 * (nn >> 7) + (nn & 127);
        if (cur.mode == 2) drow = 256 * (nn >> 7) + 128 + (nn & 127);
        *(u32x4*)(cur.WT + (size_t)drow * cur.K + cur.k0 + 8 * kc) = o;
    }
}
__device__ __forceinline__ int strip_next(int cur, int step, unsigned* ctr, int first, int tid) {
    if (!ctr) return cur + step;
    LAS int* slot = (LAS int*)((LAS unsigned char*)smem + 2 * 65536 - 64);
    __syncthreads();
    if (tid == 0) *slot = first + (int)__hip_atomic_fetch_add(ctr, 1u, __ATOMIC_RELAXED, __HIP_MEMORY_SCOPE_AGENT);
    __syncthreads();
    return *slot;
}
__device__ __forceinline__ void convert_strips(const Params& P, int first, int last, int step, unsigned* ctr = nullptr) {
    float* tile = (float*)smem;
    const int tid = opaque_tid();
    f32x4 va[8], vb[8];
    int sa = ctr ? strip_next(0, 0, ctr, first, tid) : first;
    if (sa >= last) return;
    Strip da = strip_desc(P, sa);
    strip_load(da, tid, va);
    int sb = strip_next(sa, step, ctr, first, tid);
    Strip db = da;
    if (sb < last) { db = strip_desc(P, sb); strip_load(db, tid, vb); }
    for (;;) {
        strip_lds_write(tile, tid, va);
        __syncthreads();
        const Strip ca = da;
        sa = (sb < last) ? strip_next(sb, step, ctr, first, tid) : last;
        if (sa < last) { da = strip_desc(P, sa); strip_load(da, tid, va); }
        strip_store(tile, tid, ca);
        __syncthreads();
        if (sb >= last) break;
        strip_lds_write(tile, tid, vb);
        __syncthreads();
        const Strip cb = db;
        sb = (sa < last) ? strip_next(sa, step, ctr, first, tid) : last;
        if (sb < last) { db = strip_desc(P, sb); strip_load(db, tid, vb); }
        strip_store(tile, tid, cb);
        __syncthreads();
        if (sa >= last) break;
    }
}

__device__ __forceinline__ void phase0(const Params& P) {
    unsigned char* ws = P.ws;
    const int nb = gridDim.x, b = blockIdx.x, tid = opaque_tid();
    convert_strips(P, b, S_IN + S_GLU + S_OUT + S_GU_EARLY, nb);
    const size_t gt = (size_t)b * 512 + tid, ngt = (size_t)nb * 512;
    {
        u32x4* xb = (u32x4*)(ws + WS_XB);
        for (size_t e0 = gt; e0 < (size_t)L * D / 8; e0 += 4 * ngt) {
            f32x4 a[4], c[4];
#pragma unroll
            for (int q = 0; q < 4; ++q) { const size_t e = e0 + q * ngt; if (e < (size_t)L * D / 8) { a[q] = __builtin_nontemporal_load((const f32x4*)(P.x + e * 8)); c[q] = __builtin_nontemporal_load((const f32x4*)(P.x + e * 8 + 4)); } }
#pragma unroll
            for (int q = 0; q < 4; ++q) { const size_t e = e0 + q * ngt; if (e < (size_t)L * D / 8) {
                u32x4 o; o[0] = pk2(a[q][0], a[q][1]); o[1] = pk2(a[q][2], a[q][3]); o[2] = pk2(c[q][0], c[q][1]); o[3] = pk2(c[q][2], c[q][3]);
                xb[e] = o; } }
        }
    }
    {
        float* z = (float*)(ws + WS_ROWSS);
        for (size_t e = gt; e < (size_t)L * 5; e += ngt) z[e] = 0.f;
    }
    {
        float2* lamb = (float2*)(ws + WS_LAMB); float2* ltp = (float2*)(ws + WS_LAM64);
        u32x4* BT = (u32x4*)(ws + WS_BBAR); u32x4* CTT = (u32x4*)(ws + WS_CT);
        for (size_t e = gt; e < (size_t)NG * NP; e += ngt) {
            const int g = (int)(e >> 6);
            const double dt = dexp((double)P.log_dt[g]), lr = (double)P.lam_re[e], li = (double)P.lam_im[e];
            const double mag = dexp(lr * dt); double sn, cs; dsincos(li * dt, sn, cs);
            lamb[e] = make_float2((float)(mag * cs), (float)(mag * sn));
        }
        for (size_t e = gt; e < (size_t)NG * 4 * 64; e += ngt) {
            const int ln = (int)(e & 63), kb = (int)((e >> 6) & 3), g = (int)(e >> 8);
            const int pp = (ln & 31) + 32 * (kb >> 1), gp = g * 64 + pp, h0 = 8 * (ln >> 5);
            const double dt = dexp((double)P.log_dt[g]), lr = (double)P.lam_re[gp], li = (double)P.lam_im[gp];
            const double mag = dexp(lr * dt); double sn, cs; dsincos(li * dt, sn, cs);
            const double nr = mag * cs - 1.0, ni = mag * sn, den = lr * lr + li * li;
            const double cr = (nr * lr + ni * li) / den, ci = (ni * lr - nr * li) / den;
            float v[8];
#pragma unroll
            for (int q = 0; q < 8; ++q) {
                const double br = (double)P.b_re[(size_t)gp * GH + h0 + q], bi = (double)P.b_im[(size_t)gp * GH + h0 + q];
                v[q] = (kb & 1) ? (float)(cr * bi + ci * br) : (float)(cr * br - ci * bi);
            }
            u32x4 hi, lo;
#pragma unroll
            for (int q = 0; q < 4; ++q) { hi[q] = pk2(v[2 * q], v[2 * q + 1]); lo[q] = pk2(v[2 * q] - bflo(hi[q]), v[2 * q + 1] - bfhi(hi[q])); }
            BT[((size_t)(g * 4 + kb) * 2 + 0) * 64 + ln] = hi; BT[((size_t)(g * 4 + kb) * 2 + 1) * 64 + ln] = lo;
        }
        for (size_t e = gt; e < (size_t)NG * 8 * 64; e += ngt) {
            const int ln = (int)(e & 63), kk = (int)((e >> 6) & 7), g = (int)(e >> 9);
            const int ii = ln & 15, lopart = (ln >> 4) & 1, h = 8 * ((ii >> 2) & 1) + 4 * (ii >> 3) + (ii & 3);
            float v[8];
#pragma unroll
            for (int q = 0; q < 8; ++q) {
                const int kl = 16 * kk + 8 * (ln >> 5) + q, kb = kl >> 5, pp = (kl & 31) + 32 * (kb >> 1);
                const float cv = (kb & 1) ? -P.c_im[((size_t)g * GH + h) * NP + pp] : P.c_re[((size_t)g * GH + h) * NP + pp];
                v[q] = cv;
            }
            u32x4 o;
#pragma unroll
            for (int q = 0; q < 4; ++q) {
                const unsigned hi = pk2(v[2 * q], v[2 * q + 1]);
                o[q] = lopart ? pk2(v[2 * q] - bflo(hi), v[2 * q + 1] - bfhi(hi)) : hi;
            }
            CTT[e] = o;
        }
        for (size_t e = gt; e < (size_t)NG * NP; e += ngt) {
            const int gp = (int)e, g = gp >> 6;
            const double dt = dexp((double)P.log_dt[g]), lr = (double)P.lam_re[gp], li = (double)P.lam_im[gp];
            const double sc = dt * (double)TCH;
            const double mag = dexp(lr * sc); double sn, cs; dsincos(li * sc, sn, cs);
            ltp[e] = make_float2((float)(mag * cs), (float)(mag * sn));
        }
    }
}

constexpr int BM = 256, BK = 64, HALF = 128, HT = HALF * BK, NXCD = 8, WGM = 4;
__device__ __forceinline__ int lds_byte(int r, int c) { int st = (r >> 4) * 2 + (c >> 5), rr = r & 15, cc = c & 31, ob = rr * 64 + cc * 2; return st * 1024 + (ob ^ (((ob >> 9) & 1) << 5)); }
__device__ __forceinline__ void stage_rc(int b, int& R, int& C) { int st = b / 1024, sb = b % 1024, swz = sb ^ (((sb >> 9) & 1) << 5); R = (st >> 1) * 16 + swz / 64; C = (st & 1) * 32 + (swz % 64) / 2; }

enum { EPI_PROJ = 1, EPI_GLU = 2, EPI_OUT = 3, EPI_FFN = 4, EPI_DOWN = 5 };

__device__ __forceinline__ void xcd_barrier(unsigned char* wsb);

template <int K, int EPI, bool FUSE = false>
__device__ __forceinline__ void gemm_phase(const Params& P, const bf16_t* __restrict__ A, const bf16_t* __restrict__ Bt, int nM, int nN) {
    typedef __attribute__((address_space(3))) unsigned char lds_u8;
    lds_u8* lds = (lds_u8*)smem;
    unsigned char* ws = P.ws;
    constexpr int HTB = HT * 2;
#define SA(b, h) (((b) * 2 + (h)) * HTB)
#define SB(b, h) ((4 + (b) * 2 + (h)) * HTB)
#define STAGE_B(bufoff, br, kt) do { const char* _g = (const char*)Bt + ((size_t)(br) * K + (size_t)(kt) * BK) * 2; \
        __builtin_amdgcn_global_load_lds((const unsigned*)(_g + voffB0), (__attribute__((address_space(3))) unsigned*)(lds + (bufoff) + ldsw), 16, 0, 0); \
        __builtin_amdgcn_global_load_lds((const unsigned*)(_g + voffB1), (__attribute__((address_space(3))) unsigned*)(lds + (bufoff) + ldsw + 8192), 16, 0, 0); } while (0)
#define STAGE_A(bufoff, h, kt) do { if (EPI == EPI_FFN) { const char* _g = (const char*)A + (size_t)(kt) * BK * 2; \
        __builtin_amdgcn_global_load_lds((const unsigned*)(_g + aoff[h][0]), (__attribute__((address_space(3))) unsigned*)(lds + (bufoff) + ldsw), 16, 0, 0); \
        __builtin_amdgcn_global_load_lds((const unsigned*)(_g + aoff[h][1]), (__attribute__((address_space(3))) unsigned*)(lds + (bufoff) + ldsw + 8192), 16, 0, 0); \
      } else { const char* _g = (const char*)A + ((size_t)(brow + (h) * HALF) * K + (size_t)(kt) * BK) * 2; \
        __builtin_amdgcn_global_load_lds((const unsigned*)(_g + voffA0), (__attribute__((address_space(3))) unsigned*)(lds + (bufoff) + ldsw), 16, 0, 0); \
        __builtin_amdgcn_global_load_lds((const unsigned*)(_g + voffA1), (__attribute__((address_space(3))) unsigned*)(lds + (bufoff) + ldsw + 8192), 16, 0, 0); } } while (0)
#define STAGE_AX(bufoff, AO, h, kt) do { const char* _g = (const char*)A + (size_t)(kt) * BK * 2; \
        __builtin_amdgcn_global_load_lds((const unsigned*)(_g + AO[h][0]), (__attribute__((address_space(3))) unsigned*)(lds + (bufoff) + ldsw), 16, 0, 0); \
        __builtin_amdgcn_global_load_lds((const unsigned*)(_g + AO[h][1]), (__attribute__((address_space(3))) unsigned*)(lds + (bufoff) + ldsw + 8192), 16, 0, 0); } while (0)
#define LDA(dst, b, h) do { _Pragma("unroll") for (int m = 0; m < 4; ++m) _Pragma("unroll") for (int k = 0; k < 2; ++k) \
        dst[m][k] = *(const __attribute__((address_space(3))) bf16x8*)(lds + SA(b, h) + la_off + m * 2048 + k * 1024); } while (0)
#define LDB(dst, b, h) do { _Pragma("unroll") for (int n = 0; n < 2; ++n) _Pragma("unroll") for (int k = 0; k < 2; ++k) \
        dst[n][k] = *(const __attribute__((address_space(3))) bf16x8*)(lds + SB(b, h) + lb_off + n * 2048 + k * 1024); } while (0)
#define MMA(ai, bj, At_, Bt_) do { __builtin_amdgcn_s_setprio(1); \
        _Pragma("unroll") for (int m = 0; m < 4; ++m) _Pragma("unroll") for (int n = 0; n < 2; ++n) _Pragma("unroll") for (int k = 0; k < 2; ++k) \
            acc[ai][bj][m][n] = __builtin_amdgcn_mfma_f32_16x16x32_bf16(Bt_[n][k], At_[m][k], acc[ai][bj][m][n], 0, 0, 0); \
        __builtin_amdgcn_s_setprio(0); } while (0)
#define WAIT_V(n) asm volatile("s_waitcnt vmcnt(" #n ")" ::: "memory")
#define WAIT_L(n) asm volatile("s_waitcnt lgkmcnt(" #n ")" ::: "memory")
#define BAR __builtin_amdgcn_s_barrier()
#define SCHED __builtin_amdgcn_sched_barrier(0)

    const int tid = opaque_tid(), wid = tid >> 6, wr = wid >> 2;
    const int nwg = nM * nN, G = gridDim.x;
    constexpr int nt = K / BK;

    bool pre = false;
#define TILE_OF(Lw_, pm_, pn_) do { int wgid = (Lw_); \
        { const int q = nwg / NXCD, r = nwg % NXCD, xcd = wgid % NXCD, off = wgid / NXCD; wgid = (xcd < r ? xcd * (q + 1) : r * (q + 1) + (xcd - r) * q) + off; } \
        const int nig = WGM * nN, gid = wgid / nig, fm = gid * WGM, gsz = (nM - fm) < WGM ? (nM - fm) : WGM; \
        pm_ = fm + ((wgid % nig) % gsz); pn_ = (wgid % nig) / gsz; } while (0)
#define FFN_AOFF(AO, brow_) do { _Pragma("unroll") for (int h = 0; h < 2; ++h) { \
        int r0 = (brow_) + h * HALF + sR0, r1 = (brow_) + h * HALF + sR1; \
        r0 = r0 < 0 ? 0 : (r0 > L - 1 ? L - 1 : r0); r1 = r1 < 0 ? 0 : (r1 > L - 1 ? L - 1 : r1); \
        AO[h][0] = (unsigned)(r0 * K + sC0) * 2u; AO[h][1] = (unsigned)(r1 * K + sC1) * 2u; } } while (0)
    for (int it = 0;; ++it) {
        const int Lw = it * G + blockIdx.x;
        if (Lw >= nwg) break;
        const int tidk = opaque_tid(), lanek = tidk & 63, wck = (tidk >> 6) & 3, wrk = tidk >> 8, frk = lanek & 15, fqk = lanek >> 4;
        int sR0, sR1, sC0, sC1;
        stage_rc(tidk * 16, sR0, sC0); stage_rc(tidk * 16 + 8192, sR1, sC1);
        const int sRb0 = (EPI == EPI_FFN || EPI == EPI_PROJ || EPI == EPI_GLU || EPI == EPI_OUT) ? ((sR0 & ~31) + 8 * ((sR0 & 15) >> 2) + 4 * ((sR0 & 31) >> 4) + (sR0 & 3)) : sR0;
        const int sRb1 = (EPI == EPI_FFN || EPI == EPI_PROJ || EPI == EPI_GLU || EPI == EPI_OUT) ? ((sR1 & ~31) + 8 * ((sR1 & 15) >> 2) + 4 * ((sR1 & 31) >> 4) + (sR1 & 3)) : sR1;
        const unsigned voffB0 = (unsigned)(sRb0 * K + sC0) * 2u, voffB1 = (unsigned)(sRb1 * K + sC1) * 2u;
        const unsigned voffA0 = (unsigned)(sR0 * K + sC0) * 2u, voffA1 = (unsigned)(sR1 * K + sC1) * 2u;
        const unsigned ldsw = (unsigned)(tidk >> 6) * 1024u;
        const int la_off = lds_byte(wrk * 64 + frk, fqk * 8), lb_off = lds_byte(wck * 32 + frk, fqk * 8);
        int pm, pn;
        unsigned aoff[2][2];
        TILE_OF(Lw, pm, pn);
        if (EPI == EPI_FFN) FFN_AOFF(aoff, 254 * pm - 2);
        const int brow = (EPI == EPI_FFN) ? (254 * pm - 2) : pm * BM, bcol = pn * BM;
        f32x4 acc[2][2][4][2];
#pragma unroll
        for (int a = 0; a < 2; ++a)
#pragma unroll
            for (int b2 = 0; b2 < 2; ++b2)
#pragma unroll
                for (int m = 0; m < 4; ++m)
#pragma unroll
                    for (int n = 0; n < 2; ++n) acc[a][b2][m][n] = (f32x4){0.f, 0.f, 0.f, 0.f};
        bf16x8 At[4][2], B0[2][2], B1[2][2];

        if (EPI == EPI_FFN && pre) {
            if (wr == 1) BAR;
            WAIT_V(0); BAR;
        } else {
            STAGE_B(SB(0, 0), bcol, 0); STAGE_A(SA(0, 0), 0, 0);
            STAGE_B(SB(0, 1), bcol + HALF, 0); STAGE_A(SA(0, 1), 1, 0);
            if (wr == 1) BAR;
            WAIT_V(4); BAR;
        }
        STAGE_B(SB(1, 0), bcol, 1); STAGE_A(SA(1, 0), 0, 1); STAGE_B(SB(1, 1), bcol + HALF, 1);
        WAIT_V(6); BAR;
#pragma unroll 1
        for (int t = 0; t < nt - 2; t += 2) {
            if (EPI == EPI_OUT) {
                if (t == (SW / BK)) {
                    const float* rowss = (const float*)(ws + WS_ROWSS);
#pragma unroll
                    for (int ai = 0; ai < 2; ++ai)
#pragma unroll
                        for (int m = 0; m < 4; ++m) {
                            const int row = brow + ai * HALF + wrk * 64 + m * 16 + frk;
                            const float sc = rsqrtf(rowss[row] * (1.0f / SW) + RMS_EPS);
#pragma unroll
                            for (int bj = 0; bj < 2; ++bj)
#pragma unroll
                                for (int n = 0; n < 2; ++n) acc[ai][bj][m][n] *= sc;
                        }
                }
            }
            LDB(B0, 0, 0); SCHED; LDA(At, 0, 0); STAGE_A(SA(1, 1), 1, t + 1);
            WAIT_L(8); BAR; WAIT_L(0); MMA(0, 0, At, B0); BAR; SCHED;
            LDB(B1, 0, 1); STAGE_B(SB(0, 0), bcol, t + 2);
            BAR; WAIT_L(0); MMA(0, 1, At, B1); BAR;
            LDA(At, 0, 1); STAGE_A(SA(0, 0), 0, t + 2);
            BAR; WAIT_L(0); MMA(1, 0, At, B0); BAR; SCHED;
            STAGE_B(SB(0, 1), bcol + HALF, t + 2);
            WAIT_V(6); BAR; MMA(1, 1, At, B1); BAR;
            LDB(B0, 1, 0); SCHED; LDA(At, 1, 0); STAGE_A(SA(0, 1), 1, t + 2);
            WAIT_L(8); BAR; WAIT_L(0); MMA(0, 0, At, B0); BAR; SCHED;
            LDB(B1, 1, 1); STAGE_B(SB(1, 0), bcol, t + 3);
            BAR; WAIT_L(0); MMA(0, 1, At, B1); BAR;
            LDA(At, 1, 1); STAGE_A(SA(1, 0), 0, t + 3);
            BAR; WAIT_L(0); MMA(1, 0, At, B0); BAR; SCHED;
            STAGE_B(SB(1, 1), bcol + HALF, t + 3);
            WAIT_V(6); BAR; MMA(1, 1, At, B1); BAR;
        }
        { LDB(B0, 0, 0); LDA(At, 0, 0); STAGE_A(SA(1, 1), 1, nt - 1);
          BAR; WAIT_L(0); MMA(0, 0, At, B0); BAR;
          LDB(B1, 0, 1); BAR; WAIT_L(0); MMA(0, 1, At, B1); BAR;
          LDA(At, 0, 1); WAIT_V(4); BAR; WAIT_L(0); MMA(1, 0, At, B0); MMA(1, 1, At, B1); BAR; }
        { LDB(B0, 1, 0); LDA(At, 1, 0); WAIT_V(2); BAR; WAIT_L(0); MMA(0, 0, At, B0); BAR;
          LDB(B1, 1, 1); WAIT_V(0); BAR; WAIT_L(0); MMA(0, 1, At, B1); BAR;
          LDA(At, 1, 1); BAR; WAIT_L(0); MMA(1, 0, At, B0); MMA(1, 1, At, B1); BAR; }
        if (wr == 0) BAR;

        const int tide = opaque_tid(), lane = tide & 63, wc = (tide >> 6) & 3, wre = tide >> 8, fr = lane & 15, fq = lane >> 4;
        const int row0 = brow + wre * 64 + fr, col0 = bcol + wc * 32 + 4 * fq;
        if (EPI == EPI_PROJ) {
            const int col0p = bcol + wc * 32 + 8 * fq;
            if (bcol < SW) {
                float* U = (float*)(ws + WS_U);
#pragma unroll
                for (int ai = 0; ai < 2; ++ai)
#pragma unroll
                    for (int m = 0; m < 4; ++m)
#pragma unroll
                        for (int bj = 0; bj < 2; ++bj)
#pragma unroll
                            for (int n = 0; n < 2; ++n)
                                *(f32x4*)(U + (size_t)(row0 + ai * HALF + m * 16) * SW + col0p + bj * HALF + 4 * n) = acc[ai][bj][m][n];
            } else {
                bf16_t* Gb = (bf16_t*)(ws + WS_GBCV);
#pragma unroll
                for (int ai = 0; ai < 2; ++ai)
#pragma unroll
                    for (int m = 0; m < 4; ++m)
#pragma unroll
                        for (int bj = 0; bj < 2; ++bj) {
                            const f32x4 v0 = acc[ai][bj][m][0], v1 = acc[ai][bj][m][1];
                            u32x4 o; o[0] = pk2(v0[0], v0[1]); o[1] = pk2(v0[2], v0[3]); o[2] = pk2(v1[0], v1[1]); o[3] = pk2(v1[2], v1[3]);
                            *(u32x4*)(Gb + (size_t)(row0 + ai * HALF + m * 16) * (3 * CW) + (col0p - SW) + bj * HALF) = o;
                        }
            }
        }
        if (EPI == EPI_GLU) {
            const int col0p = bcol + wc * 32 + 8 * fq;
            const bf16_t* Gg = (const bf16_t*)(ws + WS_G);
            bf16_t* Y = (bf16_t*)(ws + WS_YMIX);
            float* rowss = (float*)(ws + WS_ROWSS);
#pragma unroll
            for (int ai = 0; ai < 2; ++ai)
#pragma unroll
                for (int m = 0; m < 4; ++m) {
                    const int row = row0 + ai * HALF + m * 16;
                    float ss = 0.f;
#pragma unroll
                    for (int bj = 0; bj < 2; ++bj) {
                        const int col = col0p + bj * HALF;
                        const u32x4 gw = *(const u32x4*)(Gg + (size_t)row * SW + col);
                        u32x4 w;
#pragma unroll
                        for (int n = 0; n < 2; ++n) {
                            const f32x4 bz = *(const f32x4*)(P.glu_b + col + 4 * n), gn = *(const f32x4*)(P.nsg + col + 4 * n);
                            const f32x4 gv = (f32x4){bflo(gw[2 * n]), bfhi(gw[2 * n]), bflo(gw[2 * n + 1]), bfhi(gw[2 * n + 1])};
                            f32x4 o;
#pragma unroll
                            for (int j = 0; j < 4; ++j) { o[j] = gv[j] * sigmoidf_(acc[ai][bj][m][n][j] + bz[j]); ss += o[j] * o[j]; o[j] *= gn[j]; }
                            w[2 * n] = pk2(o[0], o[1]); w[2 * n + 1] = pk2(o[2], o[3]);
                        }
                        *(u32x4*)(Y + (size_t)row * D + col) = w;
                    }
                    ss += __shfl_xor(ss, 16); ss += __shfl_xor(ss, 32);
                    if (fq == 0) atomicAdd(rowss + row, ss);
                }
        }
        if (EPI == EPI_OUT || EPI == EPI_DOWN) {
            const float* R = (EPI == EPI_OUT) ? P.x : P.out;
            float* st = (float*)(ws + ((EPI == EPI_OUT) ? WS_ST1 : WS_ST2));
#pragma unroll
            for (int ai = 0; ai < 2; ++ai)
#pragma unroll
                for (int m = 0; m < 4; ++m) {
                    const int row = row0 + ai * HALF + m * 16;
                    float s1 = 0.f, s2 = 0.f;
#pragma unroll
                    for (int bj = 0; bj < 2; ++bj)
#pragma unroll
                        for (int n = 0; n < 2; ++n) {
                            const int col = (EPI == EPI_OUT) ? (bcol + wc * 32 + 8 * fq + bj * HALF + 4 * n) : (col0 + bj * HALF + n * 16);
                            const f32x4 rv = __builtin_nontemporal_load((const f32x4*)(R + (size_t)row * D + col));
                            f32x4 o;
#pragma unroll
                            for (int j = 0; j < 4; ++j) { o[j] = ALPHA * rv[j] + acc[ai][bj][m][n][j]; s1 += o[j]; s2 += o[j] * o[j]; }
                            if (FUSE) acc[ai][bj][m][n] = o; else *(f32x4*)(P.out + (size_t)row * D + col) = o;
                        }
                    s1 += __shfl_xor(s1, 16); s1 += __shfl_xor(s1, 32);
                    s2 += __shfl_xor(s2, 16); s2 += __shfl_xor(s2, 32);
                    if (fq == 0) { atomicAdd(st + 2 * row, s1); atomicAdd(st + 2 * row + 1, s2); }
                }
            if (FUSE) {
                xcd_barrier(P.ws);
                const int tf = opaque_tid(), lf = tf & 63, r0f = brow + (tf >> 8) * 64 + (lf & 15), c0f = bcol + ((tf >> 6) & 3) * 32 + ((EPI == EPI_OUT) ? 8 : 4) * (lf >> 4);
                const float* gam = (EPI == EPI_OUT) ? P.ln1g : P.ln2g; const float* bet = (EPI == EPI_OUT) ? P.ln1b : P.ln2b;
                bf16_t* HB = (bf16_t*)(ws + WS_H1B);
#pragma unroll
                for (int ai = 0; ai < 2; ++ai)
#pragma unroll
                    for (int m = 0; m < 4; ++m) {
                        const int row = r0f + ai * HALF + m * 16;
                        const float s1 = __hip_atomic_load(st + 2 * row, __ATOMIC_RELAXED, __HIP_MEMORY_SCOPE_AGENT), s2 = __hip_atomic_load(st + 2 * row + 1, __ATOMIC_RELAXED, __HIP_MEMORY_SCOPE_AGENT);
                        const float mean = s1 * (1.0f / D);
                        const float rstd = rsqrtf(fmaxf(s2 * (1.0f / D) - mean * mean, 0.f) + LN_EPS);
#pragma unroll
                        for (int bj = 0; bj < 2; ++bj) {
                            u32x4 wb;
#pragma unroll
                            for (int n = 0; n < 2; ++n) {
                                const int col = c0f + bj * HALF + n * ((EPI == EPI_OUT) ? 4 : 16);
                                const f32x4 gv = *(const f32x4*)(gam + col), bv = *(const f32x4*)(bet + col);
                                f32x4 o;
#pragma unroll
                                for (int j = 0; j < 4; ++j) o[j] = (acc[ai][bj][m][n][j] - mean) * rstd * gv[j] + bv[j];
                                *(f32x4*)(P.out + (size_t)row * D + col) = o;
                                wb[2 * n] = pk2(o[0], o[1]); wb[2 * n + 1] = pk2(o[2], o[3]);
                            }
                            if (EPI == EPI_OUT) *(u32x4*)(HB + (size_t)row * D + c0f + bj * HALF) = wb;
                        }
                    }
            }
        }
        if (EPI == EPI_FFN) {
            f32x4 w0[2], w1[2], w2[2], cb[2];
            const int c0 = pn * 128 + wc * 32 + 8 * fq;
#pragma unroll
            for (int n = 0; n < 2; ++n) {
                const int c = c0 + 4 * n;
                w0[n] = *(const f32x4*)(P.fcw + c); w1[n] = *(const f32x4*)(P.fcw + DFF + c); w2[n] = *(const f32x4*)(P.fcw + 2 * DFF + c); cb[n] = *(const f32x4*)(P.fcb + c);
            }
            pre = false;
            LAS unsigned char* Gs = (LAS unsigned char*)smem + 65536;
            const int ch = 4 * wc + fq;
#pragma unroll
            for (int ai = 0; ai < 2; ++ai)
#pragma unroll
                for (int m = 0; m < 4; ++m) {
                    const int rl = ai * HALF + wre * 64 + m * 16 + fr;
                    f32x4 v0 = acc[ai][0][m][0], v1 = acc[ai][0][m][1];
                    if (brow + rl < 0) { v0 = (f32x4){0.f, 0.f, 0.f, 0.f}; v1 = v0; }
                    u32x4 w; w[0] = pk2(v0[0], v0[1]); w[1] = pk2(v0[2], v0[3]); w[2] = pk2(v1[0], v1[1]); w[3] = pk2(v1[2], v1[3]);
                    *(LAS u32x4*)(Gs + rl * 256 + ((ch ^ (rl & 15)) << 4)) = w;
                }
            __syncthreads();
            bf16_t* ACT = (bf16_t*)(ws + WS_ACT);
#pragma unroll
            for (int ai = 0; ai < 2; ++ai)
#pragma unroll
                for (int m = 0; m < 4; ++m) {
                    const int rl = ai * HALF + wre * 64 + m * 16 + fr, grow = brow + rl;
                    if (rl >= 2 && grow < L) {
                        const u32x4 a1 = *(const LAS u32x4*)(Gs + (rl - 1) * 256 + ((ch ^ ((rl - 1) & 15)) << 4));
                        const u32x4 a2 = *(const LAS u32x4*)(Gs + (rl - 2) * 256 + ((ch ^ ((rl - 2) & 15)) << 4));
                        u32x4 w;
#pragma unroll
                        for (int n = 0; n < 2; ++n) {
                            const f32x4 g1 = (f32x4){bflo(a1[2 * n]), bfhi(a1[2 * n]), bflo(a1[2 * n + 1]), bfhi(a1[2 * n + 1])};
                            const f32x4 g2 = (f32x4){bflo(a2[2 * n]), bfhi(a2[2 * n]), bflo(a2[2 * n + 1]), bfhi(a2[2 * n + 1])};
                            const f32x4 g0 = acc[ai][0][m][n], up = acc[ai][1][m][n];
                            f32x4 o;
                            { const f32x4 a4 = w0[n] * g2 + w1[n] * g1 + w2[n] * g0 + cb[n];
                              f32x4 e4; e4[0] = __expf(-a4[0]); e4[1] = __expf(-a4[1]); e4[2] = __expf(-a4[2]); e4[3] = __expf(-a4[3]);
                              const f32x4 d4 = e4 + 1.0f;
                              f32x4 r4; r4[0] = __builtin_amdgcn_rcpf(d4[0]); r4[1] = __builtin_amdgcn_rcpf(d4[1]); r4[2] = __builtin_amdgcn_rcpf(d4[2]); r4[3] = __builtin_amdgcn_rcpf(d4[3]);
                              o = a4 * r4 * up; }
                            w[2 * n] = pk2(o[0], o[1]); w[2 * n + 1] = pk2(o[2], o[3]);
                        }
                        *(u32x4*)(ACT + (size_t)grow * DFF + c0) = w;
                    }
                }
            __syncthreads();
        }
    }
#undef TILE_OF
#undef FFN_AOFF
#undef STAGE_AX
#undef SA
#undef SB
#undef STAGE_A
#undef STAGE_B
#undef LDA
#undef LDB
#undef MMA
}

using f32x16 = __attribute__((ext_vector_type(16))) float;
typedef short s16x4 __attribute__((ext_vector_type(4)));
#define MFMA32(a, b, c) __builtin_amdgcn_mfma_f32_32x32x16_bf16((a), (b), (c), 0, 0, 0)
__device__ __forceinline__ bf16x8 as_bf16x8(u32x4 v) { return __builtin_bit_cast(bf16x8, v); }
#define CMUL_R(ar, ai, br, bi) ((ar) * (br) - (ai) * (bi))
#define CMUL_I(ar, ai, br, bi) ((ar) * (bi) + (ai) * (br))

template <bool PASSB, bool LOCAL = false>
__device__ __forceinline__ void ssm_phase(const Params& P) {
    unsigned char* ws = P.ws;
    const int tid = opaque_tid(), wid = tid >> 6, lane = tid & 63, pj = lane & 31, hf = lane >> 5;
    LAS unsigned char* xt = (LAS unsigned char*)smem + wid * 9216;
    LAS u32x4* bts = (LAS u32x4*)((LAS unsigned char*)smem + 8 * 9216 + 8192);
    LAS u32x4* cts = (LAS u32x4*)((LAS unsigned char*)smem + 8 * 9216);
    const float* U = (const float*)(ws + WS_U);
    const float2* lamb = (const float2*)(ws + WS_LAMB); const float2* Cin = (const float2*)(ws + WS_CIN); float2* F = (float2*)(ws + WS_F);
    const u32x4* BT = (const u32x4*)(ws + WS_BBAR); const u32x4* CTT = (const u32x4*)(ws + WS_CT);
    bf16_t* Gout = (bf16_t*)(ws + WS_G);
    typedef float f32x2v __attribute__((ext_vector_type(2)));
    LAS f32x2v* Fl = (LAS f32x2v*)((LAS unsigned char*)smem + 8 * 9216 + 16384);
    float2* QT = (float2*)(ws + WS_CIN);
    const float2* l64g = (const float2*)(ws + WS_LAM64);
    for (int it = blockIdx.x; it < NG * 4; it += gridDim.x) {
      const int g = it & 63, cq = it >> 6;
      __syncthreads();
      bts[tid] = BT[(size_t)g * 512 + tid];
      if (PASSB) cts[tid] = CTT[(size_t)g * 512 + tid];
      if (PASSB && LOCAL && wid == 0) {
          const float2 lm = l64g[g * 64 + lane];
          float pr = lm.x, pi_ = lm.y;
#pragma unroll
          for (int k = 0; k < 5; ++k) { const float nr = CMUL_R(pr, pi_, pr, pi_), ni = CMUL_I(pr, pi_, pr, pi_); pr = nr; pi_ = ni; }
          float sr = 0.f, si = 0.f;
          for (int q = 0; q < cq; ++q) { const float2 tq = QT[((size_t)g * 4 + q) * 64 + lane]; const float nr = CMUL_R(pr, pi_, sr, si) + tq.x, ni = CMUL_I(pr, pi_, sr, si) + tq.y; sr = nr; si = ni; }
          float wr_ = sr, wi_ = si;
          for (int ci2 = 0; ci2 < 32; ++ci2) {
              const f32x2v pf = Fl[ci2 * 64 + lane];
              Fl[ci2 * 64 + lane] = (f32x2v){pf.x + wr_, pf.y + wi_};
              const float nr = CMUL_R(lm.x, lm.y, wr_, wi_), ni = CMUL_I(lm.x, lm.y, wr_, wi_); wr_ = nr; wi_ = ni;
          }
      }
      __syncthreads();
      const float2 lA = lamb[g * 64 + pj], lB = lamb[g * 64 + pj + 32];
      float l1[2][2] = {{lA.x, lA.y}, {lB.x, lB.y}}, l2[2][2], l3[2][2], l4[2][2];
#pragma unroll
      for (int sbi = 0; sbi < 2; ++sbi) {
          l2[sbi][0] = CMUL_R(l1[sbi][0], l1[sbi][1], l1[sbi][0], l1[sbi][1]); l2[sbi][1] = CMUL_I(l1[sbi][0], l1[sbi][1], l1[sbi][0], l1[sbi][1]);
          l3[sbi][0] = CMUL_R(l2[sbi][0], l2[sbi][1], l1[sbi][0], l1[sbi][1]); l3[sbi][1] = CMUL_I(l2[sbi][0], l2[sbi][1], l1[sbi][0], l1[sbi][1]);
          l4[sbi][0] = CMUL_R(l2[sbi][0], l2[sbi][1], l2[sbi][0], l2[sbi][1]); l4[sbi][1] = CMUL_I(l2[sbi][0], l2[sbi][1], l2[sbi][0], l2[sbi][1]);
      }
      const int i16 = lane & 15;
      const int traddr = (8 * hf + (i16 >> 2)) * 72 + (16 * ((lane >> 4) & 1) + 4 * (i16 & 3)) * 2;
      if (!PASSB) {
          float l5[2][2], l32[2][2];
#pragma unroll
          for (int sbi = 0; sbi < 2; ++sbi) {
              l5[sbi][0] = CMUL_R(l4[sbi][0], l4[sbi][1], l1[sbi][0], l1[sbi][1]); l5[sbi][1] = CMUL_I(l4[sbi][0], l4[sbi][1], l1[sbi][0], l1[sbi][1]);
              float ar = l4[sbi][0], ai = l4[sbi][1];
#pragma unroll
              for (int k = 0; k < 3; ++k) { const float nr = CMUL_R(ar, ai, ar, ai), ni = CMUL_I(ar, ai, ar, ai); ar = nr; ai = ni; }
              l32[sbi][0] = ar; l32[sbi][1] = ai;
          }
#pragma unroll 1
          for (int kp = 0; kp < 4; kp += 2) {
              float cr2[2][2] = {{0.f, 0.f}, {0.f, 0.f}}, ci2[2][2] = {{0.f, 0.f}, {0.f, 0.f}};
#pragma unroll 1
              for (int tb = 0; tb < 2; ++tb) {
                  f32x16 z2[2][4];
#pragma unroll
                  for (int j = 0; j < 2; ++j) {
                      const int t0 = (cq * 32 + wid + 8 * (kp + j)) * TCH;
                      const float* up = U + (size_t)(t0 + 32 * tb + pj) * SW + g * GH + 8 * hf;
                      const f32x4 u0 = *(const f32x4*)up, u1 = *(const f32x4*)(up + 4);
                      u32x4 hi, lo;
#pragma unroll
                      for (int q = 0; q < 4; ++q) {
                          const float a = (q < 2 ? u0 : u1)[2 * (q & 1)], b = (q < 2 ? u0 : u1)[2 * (q & 1) + 1];
                          hi[q] = pk2(a, b); lo[q] = pk2(a - bflo(hi[q]), b - bfhi(hi[q]));
                      }
                      const bf16x8 uh = as_bf16x8(hi), ul = as_bf16x8(lo);
#pragma unroll
                      for (int kb = 0; kb < 4; ++kb) {
                          const bf16x8 bhk = as_bf16x8(bts[(kb * 2 + 0) * 64 + lane]), blk = as_bf16x8(bts[(kb * 2 + 1) * 64 + lane]);
                          f32x16 acc;
#pragma unroll
                          for (int r = 0; r < 16; ++r) acc[r] = 0.f;
                          acc = MFMA32(uh, bhk, acc); acc = MFMA32(ul, bhk, acc); acc = MFMA32(uh, blk, acc);
                          z2[j][kb] = acc;
                      }
                  }
#pragma unroll
                  for (int j = 0; j < 2; ++j)
#pragma unroll
                      for (int sbi = 0; sbi < 2; ++sbi) {
                          float hr = z2[j][2 * sbi][0], hi_ = z2[j][2 * sbi + 1][0];
#pragma unroll
                          for (int r = 1; r < 16; ++r) {
                              const float fr_ = (r & 3) ? l1[sbi][0] : l5[sbi][0], fi_ = (r & 3) ? l1[sbi][1] : l5[sbi][1];
                              const float nr = CMUL_R(fr_, fi_, hr, hi_) + z2[j][2 * sbi][r], ni = CMUL_I(fr_, fi_, hr, hi_) + z2[j][2 * sbi + 1][r];
                              hr = nr; hi_ = ni;
                          }
                          const float or_ = __shfl_xor(hr, 32), oi_ = __shfl_xor(hi_, 32);
                          const float h0r = hf ? or_ : hr, h0i = hf ? oi_ : hi_, h1r = hf ? hr : or_, h1i = hf ? hi_ : oi_;
                          const float er = CMUL_R(l4[sbi][0], l4[sbi][1], h0r, h0i) + h1r, ei = CMUL_I(l4[sbi][0], l4[sbi][1], h0r, h0i) + h1i;
                          const float c0r = cr2[j][sbi], c0i = ci2[j][sbi];
                          cr2[j][sbi] = CMUL_R(l32[sbi][0], l32[sbi][1], c0r, c0i) + er; ci2[j][sbi] = CMUL_I(l32[sbi][0], l32[sbi][1], c0r, c0i) + ei;
                      }
              }
#pragma unroll
              for (int j = 0; j < 2; ++j) {
                  const int k4j = kp + j, cj = cq * 32 + wid + 8 * k4j;
                  const float2 fv = make_float2(hf ? cr2[j][1] : cr2[j][0], hf ? ci2[j][1] : ci2[j][0]);
                  if (LOCAL) Fl[(wid + 8 * k4j) * 64 + lane] = (f32x2v){fv.x, fv.y}; else F[(size_t)cj * 4096 + g * 64 + lane] = fv;
              }
          }
      } else
      for (int k4 = 0; k4 < 4; ++k4) {
        const int c = cq * 32 + wid + 8 * k4, t0 = c * TCH;
        float cr[2] = {0.f, 0.f}, ci[2] = {0.f, 0.f};
        if (PASSB) {
            float2 cv;
            if (LOCAL) { const f32x2v t2 = Fl[(wid + 8 * k4) * 64 + lane]; cv = make_float2(t2.x, t2.y); } else cv = Cin[(size_t)c * 4096 + g * 64 + lane];
            cr[0] = __shfl(cv.x, pj); ci[0] = __shfl(cv.y, pj); cr[1] = __shfl(cv.x, pj + 32); ci[1] = __shfl(cv.y, pj + 32);
        }
#pragma unroll 1
        for (int tb = 0; tb < 2; ++tb) {
            f32x4 u[2]; bf16x8 uh, ul;
            {
                const float* up = U + (size_t)(t0 + 32 * tb + pj) * SW + g * GH + 8 * hf;
                u[0] = *(const f32x4*)up; u[1] = *(const f32x4*)(up + 4);
                u32x4 hi, lo;
#pragma unroll
                for (int q = 0; q < 4; ++q) {
                    const float a = u[q >> 1][2 * (q & 1)], b = u[q >> 1][2 * (q & 1) + 1];
                    hi[q] = pk2(a, b); lo[q] = pk2(a - bflo(hi[q]), b - bfhi(hi[q]));
                }
                uh = as_bf16x8(hi); ul = as_bf16x8(lo);
            }
            f32x16 z[4];
#pragma unroll
            for (int kb = 0; kb < 4; ++kb) {
                const bf16x8 bhk = as_bf16x8(bts[(kb * 2 + 0) * 64 + lane]), blk = as_bf16x8(bts[(kb * 2 + 1) * 64 + lane]);
                f32x16 acc;
#pragma unroll
                for (int r = 0; r < 16; ++r) acc[r] = 0.f;
                acc = MFMA32(uh, bhk, acc); acc = MFMA32(ul, bhk, acc); acc = MFMA32(uh, blk, acc);
                z[kb] = acc;
            }
#pragma unroll
            for (int sbi = 0; sbi < 2; ++sbi)
#pragma unroll
                for (int q = 0; q < 4; ++q)
#pragma unroll
                    for (int sx = 1; sx < 4; ++sx) {
                        const int r = 4 * q + sx;
                        const float xr = z[2 * sbi][r - 1], xi = z[2 * sbi + 1][r - 1];
                        z[2 * sbi][r] += CMUL_R(l1[sbi][0], l1[sbi][1], xr, xi);
                        z[2 * sbi + 1][r] += CMUL_I(l1[sbi][0], l1[sbi][1], xr, xi);
                    }
#pragma unroll
            for (int q = 0; q < 4; ++q)
#pragma unroll
                for (int sbi = 0; sbi < 2; ++sbi) {
                    const float owr = z[2 * sbi][4 * q + 3], owi = z[2 * sbi + 1][4 * q + 3];
                    const float otr = __shfl_xor(owr, 32), oti = __shfl_xor(owi, 32);
                    const float ear = hf ? otr : owr, eai = hf ? oti : owi, ebr = hf ? owr : otr, ebi = hf ? owi : oti;
                    const float c0r = cr[sbi], c0i = ci[sbi];
                    const float c1r = CMUL_R(l4[sbi][0], l4[sbi][1], c0r, c0i) + ear, c1i = CMUL_I(l4[sbi][0], l4[sbi][1], c0r, c0i) + eai;
                    const float c2r = CMUL_R(l4[sbi][0], l4[sbi][1], c1r, c1i) + ebr, c2i = CMUL_I(l4[sbi][0], l4[sbi][1], c1r, c1i) + ebi;
                    if (PASSB) {
                        const float mr = hf ? c1r : c0r, mi = hf ? c1i : c0i;
                        z[2 * sbi][4 * q + 0] += CMUL_R(l1[sbi][0], l1[sbi][1], mr, mi); z[2 * sbi + 1][4 * q + 0] += CMUL_I(l1[sbi][0], l1[sbi][1], mr, mi);
                        z[2 * sbi][4 * q + 1] += CMUL_R(l2[sbi][0], l2[sbi][1], mr, mi); z[2 * sbi + 1][4 * q + 1] += CMUL_I(l2[sbi][0], l2[sbi][1], mr, mi);
                        z[2 * sbi][4 * q + 2] += CMUL_R(l3[sbi][0], l3[sbi][1], mr, mi); z[2 * sbi + 1][4 * q + 2] += CMUL_I(l3[sbi][0], l3[sbi][1], mr, mi);
                        z[2 * sbi][4 * q + 3] += CMUL_R(l4[sbi][0], l4[sbi][1], mr, mi); z[2 * sbi + 1][4 * q + 3] += CMUL_I(l4[sbi][0], l4[sbi][1], mr, mi);
                    }
                    cr[sbi] = c2r; ci[sbi] = c2i;
                }
            if (PASSB) {
#pragma unroll
                for (int kb = 0; kb < 4; ++kb)
#pragma unroll
                    for (int q = 0; q < 4; ++q) {
                        u32x2 w; w[0] = pk2(z[kb][4 * q], z[kb][4 * q + 1]); w[1] = pk2(z[kb][4 * q + 2], z[kb][4 * q + 3]);
                        *(LAS u32x2*)(xt + (32 * kb + pj) * 72 + (8 * q + 4 * hf) * 2) = w;
                    }
                f32x16 y;
#pragma unroll
                for (int r = 0; r < 16; ++r) y[r] = 0.f;
#pragma unroll 2
                for (int kk = 0; kk < 8; ++kk) {
                    const bf16x8 af = as_bf16x8(cts[kk * 64 + lane]);
                    const s16x4 b0 = __builtin_amdgcn_ds_read_tr16_b64_v4i16((LAS s16x4*)(xt + traddr + (16 * kk) * 72));
                    const s16x4 b1 = __builtin_amdgcn_ds_read_tr16_b64_v4i16((LAS s16x4*)(xt + traddr + (16 * kk + 4) * 72));
                    bf16x8 bf; bf[0] = b0[0]; bf[1] = b0[1]; bf[2] = b0[2]; bf[3] = b0[3]; bf[4] = b1[0]; bf[5] = b1[1]; bf[6] = b1[2]; bf[7] = b1[3];
                    y = MFMA32(af, bf, y);
                }
                const f32x4 dv0 = *(const f32x4*)(P.ssm_d + g * GH + 8 * hf), dv1 = *(const f32x4*)(P.ssm_d + g * GH + 8 * hf + 4);
                float o[8];
#pragma unroll
                for (int q = 0; q < 2; ++q)
#pragma unroll
                    for (int sx = 0; sx < 4; ++sx) {
                        const float yv = y[4 * q + sx] + y[4 * (q + 2) + sx] + (q ? dv1[sx] : dv0[sx]) * u[q][sx];
                        o[4 * q + sx] = gelu_tanh(yv);
                    }
                u32x4 w; w[0] = pk2(o[0], o[1]); w[1] = pk2(o[2], o[3]); w[2] = pk2(o[4], o[5]); w[3] = pk2(o[6], o[7]);
                *(u32x4*)(Gout + (size_t)(t0 + 32 * tb + pj) * SW + g * GH + 8 * hf) = w;
            }
        }
        if (!PASSB) {
            const float2 fv = make_float2(hf ? cr[1] : cr[0], hf ? ci[1] : ci[0]);
            if (LOCAL) Fl[(wid + 8 * k4) * 64 + lane] = (f32x2v){fv.x, fv.y}; else F[(size_t)c * 4096 + g * 64 + lane] = fv;
        }
      }
      if (!PASSB && LOCAL) {
          __syncthreads();
          if (wid == 0) {
              const float2 lm = l64g[g * 64 + lane];
              float xr = 0.f, xi = 0.f;
              for (int ci2 = 0; ci2 < 32; ++ci2) {
                  const f32x2v f = Fl[ci2 * 64 + lane];
                  Fl[ci2 * 64 + lane] = (f32x2v){xr, xi};
                  const float nr = CMUL_R(lm.x, lm.y, xr, xi) + f.x, ni = CMUL_I(lm.x, lm.y, xr, xi) + f.y; xr = nr; xi = ni;
              }
              QT[((size_t)g * 4 + cq) * 64 + lane] = make_float2(xr, xi);
          }
      }
    }
}

__device__ __forceinline__ void carry_phase(const Params& P) {
    unsigned char* ws = P.ws;
    const int tid = opaque_tid();
    if (tid >= 64) return;
    const float2* F = (const float2*)(ws + WS_F); float2* Cin = (float2*)(ws + WS_CIN); const float2* l64 = (const float2*)(ws + WS_LAM64);
    const int per = (NG * NP + (int)gridDim.x - 1) / (int)gridDim.x;
    for (int k0 = 0; k0 < per; k0 += 64) {
        const int li = k0 + tid, gp = blockIdx.x * per + li;
        if (li >= per || gp >= NG * NP) continue;
        const float2 lm = l64[gp];
        float xr = 0.f, xi = 0.f;
#pragma unroll 1
        for (int c0 = 0; c0 < NCH; c0 += 32) {
            float2 f[32];
#pragma unroll
            for (int k = 0; k < 32; ++k) f[k] = F[(size_t)(c0 + k) * 4096 + gp];
#pragma unroll
            for (int k = 0; k < 32; ++k) {
                Cin[(size_t)(c0 + k) * 4096 + gp] = make_float2(xr, xi);
                const float nr = lm.x * xr - lm.y * xi + f[k].x, ni = lm.x * xi + lm.y * xr + f[k].y;
                xr = nr; xi = ni;
            }
        }
    }
}

__device__ __forceinline__ void sconv_load(const bf16_t* Gb, int t, int lane, u32x4 (&r)[6]) {
    const bf16_t* row = Gb + (size_t)t * (3 * CW) + 8 * lane;
#pragma unroll
    for (int i = 0; i < 2; ++i) { r[3 * i] = __builtin_nontemporal_load((const u32x4*)(row + 512 * i)); r[3 * i + 1] = __builtin_nontemporal_load((const u32x4*)(row + CW + 512 * i)); r[3 * i + 2] = __builtin_nontemporal_load((const u32x4*)(row + 2 * CW + 512 * i)); }
}
__device__ __forceinline__ void sconv_prod(const u32x4 (&r)[6], float (&p)[16]) {
#pragma unroll
    for (int i = 0; i < 2; ++i)
#pragma unroll
        for (int q = 0; q < 4; ++q) { p[8 * i + 2 * q] = bflo(r[3 * i + 1][q]) * bflo(r[3 * i + 2][q]); p[8 * i + 2 * q + 1] = bfhi(r[3 * i + 1][q]) * bfhi(r[3 * i + 2][q]); }
}
template <bool ALLW = false>
__device__ __forceinline__ void sconv_phase(const Params& P, int b0, int nbk) {
    unsigned char* ws = P.ws;
    if ((int)blockIdx.x < b0) return;
    const int tid = opaque_tid(), wid = tid >> 6, lane = tid & 63;
    const bf16_t* Gb = (const bf16_t*)(ws + WS_GBCV);
    bf16_t* Y = (bf16_t*)(ws + WS_YMIX);
    if (!ALLW && wid == 0) return;
    const int NWV = ALLW ? 8 : 7, W = nbk * NWV, w = ((int)blockIdx.x - b0) * NWV + (ALLW ? wid : wid - 1), R = (L + W - 1) / W, tb = w * R, te = (tb + R < L) ? tb + R : L;
    if (tb >= te) return;
    float w0[16], w1[16], w2[16], gn[16];
#pragma unroll
    for (int i = 0; i < 2; ++i)
#pragma unroll
        for (int q = 0; q < 2; ++q) {
            const int c = 8 * lane + 512 * i + 4 * q;
            const f32x4 a = *(const f32x4*)(P.sconv_w + c), b = *(const f32x4*)(P.sconv_w + CW + c), d = *(const f32x4*)(P.sconv_w + 2 * CW + c), g = *(const f32x4*)(P.ncg + c);
#pragma unroll
            for (int j = 0; j < 4; ++j) { w0[8 * i + 4 * q + j] = a[j]; w1[8 * i + 4 * q + j] = b[j]; w2[8 * i + 4 * q + j] = d[j]; gn[8 * i + 4 * q + j] = g[j]; }
        }
    float p2[16], p1[16];
    u32x4 r[6];
#pragma unroll
    for (int k = 0; k < 16; ++k) { p2[k] = 0.f; p1[k] = 0.f; }
    if (tb >= 2) { sconv_load(Gb, tb - 2, lane, r); sconv_prod(r, p2); }
    if (tb >= 1) { sconv_load(Gb, tb - 1, lane, r); sconv_prod(r, p1); }
    sconv_load(Gb, tb, lane, r);
    for (int t = tb; t < te; ++t) {
        u32x4 rn[6];
        const int tn = (t + 1 < te) ? t + 1 : t;
        sconv_load(Gb, tn, lane, rn);
        float p0[16], y[16]; float ss = 0.f;
        sconv_prod(r, p0);
#pragma unroll
        for (int i = 0; i < 2; ++i)
#pragma unroll
            for (int q = 0; q < 4; ++q) {
                const int k = 8 * i + 2 * q;
                y[k] = bflo(r[3 * i][q]) * (w0[k] * p2[k] + w1[k] * p1[k] + w2[k] * p0[k]);
                y[k + 1] = bfhi(r[3 * i][q]) * (w0[k + 1] * p2[k + 1] + w1[k + 1] * p1[k + 1] + w2[k + 1] * p0[k + 1]);
                ss += y[k] * y[k] + y[k + 1] * y[k + 1];
            }
#pragma unroll
        for (int o = 1; o < 64; o <<= 1) ss += __shfl_xor(ss, o);
        const float sc = rsqrtf(ss * (1.0f / CW) + RMS_EPS);
#pragma unroll
        for (int i = 0; i < 2; ++i) {
            u32x4 o;
#pragma unroll
            for (int q = 0; q < 4; ++q) o[q] = pk2(y[8 * i + 2 * q] * sc * gn[8 * i + 2 * q], y[8 * i + 2 * q + 1] * sc * gn[8 * i + 2 * q + 1]);
            *(u32x4*)(Y + (size_t)t * D + CW + 8 * lane + 512 * i) = o;
        }
#pragma unroll
        for (int k = 0; k < 16; ++k) { p2[k] = p1[k]; p1[k] = p0[k]; }
#pragma unroll
        for (int k = 0; k < 6; ++k) r[k] = rn[k];
    }
}

__device__ __forceinline__ void glu_sconv_phase(const Params& P) {
    unsigned char* ws = P.ws;
    gemm_phase<SW, EPI_GLU>(P, (const bf16_t*)(ws + WS_G), (const bf16_t*)(ws + WS_WGLU), L / BM, SW / BM);
    constexpr int S0 = S_IN + S_GLU + S_OUT + S_GU_EARLY;
    __syncthreads();
    convert_strips(P, S0, S_EARLY, 1, (unsigned*)(ws + WS_BAR) + XCD_BAR_WORDS);
}

__device__ __forceinline__ void ffn_phase(const Params& P) {
    unsigned char* ws = P.ws;
    constexpr int NM = 33, NN = 2 * DFF / BM;
    gemm_phase<D, EPI_FFN>(P, (const bf16_t*)(ws + WS_H1B), (const bf16_t*)(ws + WS_WGU), NM, NN);
    const int G = gridDim.x, rem = (NM * NN) % G, b = blockIdx.x;
    __syncthreads();
    if (rem == 0) convert_strips(P, S_EARLY + b, S_EARLY + S_D, G);
    else if (b >= rem) convert_strips(P, S_EARLY + (b - rem), S_EARLY + S_D, G - rem);
}

template <bool FIRST>
__device__ __forceinline__ void ln_phase(const Params& P) {
    unsigned char* ws = P.ws;
    const int tid = opaque_tid(), wid = tid >> 6, lane = tid & 63;
    const float* st = (const float*)(ws + (FIRST ? WS_ST1 : WS_ST2));
    const float* gam = FIRST ? P.ln1g : P.ln2g; const float* bet = FIRST ? P.ln1b : P.ln2b;
    bf16_t* HB = (bf16_t*)(ws + WS_H1B);
    for (int t = blockIdx.x * 8 + wid; t < L; t += gridDim.x * 8) {
        const float mean = st[2 * t] * (1.0f / D);
        const float var = fmaxf(st[2 * t + 1] * (1.0f / D) - mean * mean, 0.f);
        const float rstd = rsqrtf(var + LN_EPS);
        float* row = P.out + (size_t)t * D;
#pragma unroll
        for (int i = 0; i < 4; ++i) {
            const int c = 8 * lane + 512 * i;
            const f32x4 a = *(const f32x4*)(row + c), b = *(const f32x4*)(row + c + 4);
            const f32x4 g0 = *(const f32x4*)(gam + c), g1 = *(const f32x4*)(gam + c + 4), b0 = *(const f32x4*)(bet + c), b1 = *(const f32x4*)(bet + c + 4);
            f32x4 o0, o1;
#pragma unroll
            for (int j = 0; j < 4; ++j) { o0[j] = (a[j] - mean) * rstd * g0[j] + b0[j]; o1[j] = (b[j] - mean) * rstd * g1[j] + b1[j]; }
            *(f32x4*)(row + c) = o0; *(f32x4*)(row + c + 4) = o1;
            if (FIRST) { u32x4 o; o[0] = pk2(o0[0], o0[1]); o[1] = pk2(o0[2], o0[3]); o[2] = pk2(o1[0], o1[1]); o[3] = pk2(o1[2], o1[3]); *(u32x4*)(HB + (size_t)t * D + c) = o; }
        }
    }
}


#define XB_SPIN_CAP (1u << 22)
__device__ __forceinline__ unsigned xb_ld(unsigned* p)              { return __hip_atomic_load(p, __ATOMIC_RELAXED, __HIP_MEMORY_SCOPE_AGENT); }
__device__ __forceinline__ unsigned xb_add(unsigned* p, unsigned v) { return __hip_atomic_fetch_add(p, v, __ATOMIC_RELAXED, __HIP_MEMORY_SCOPE_AGENT); }
__device__ __forceinline__ unsigned xb_xcc_id() { return (unsigned)__builtin_amdgcn_s_getreg((3 << 11) | 20) & 0xFu; }
#define XB_SPIN(cond, bar) do { unsigned _sp = 0; while (cond) { __builtin_amdgcn_s_sleep(1); \
    if ((++_sp & 255u) == 0u) { if (xb_ld(&(bar)[XB_TMO])) break; if (_sp > XB_SPIN_CAP) { atomicAdd(&(bar)[XB_TMO], 1u); break; } } } } while (0)
struct XcdBarrier { unsigned* bar; unsigned x; volatile LAS unsigned* st; };
__device__ __forceinline__ XcdBarrier xcd_barrier_post(unsigned* bar, volatile LAS unsigned* st) {
    XcdBarrier b; b.bar = bar; b.x = xb_xcc_id(); b.st = st;
    if (threadIdx.x == 0) (void)xb_add(&bar[XB_XCNT(b.x)], 1u);
    return b;
}
__device__ __forceinline__ void xcd_barrier_complete(unsigned* bar, unsigned x, unsigned& nloc, unsigned& nx) {
    const unsigned G = gridDim.x * gridDim.y * gridDim.z;
    unsigned sum, cnt, mine, sp = 0u;
    for (;;) {
        sum = 0u; cnt = 0u; mine = 0u;
#pragma unroll
        for (unsigned j = 0; j < 16; ++j) { const unsigned c = xb_ld(&bar[XB_XCNT(j)]); sum += c; cnt += (c > 0u) ? 1u : 0u; mine = (j == x) ? c : mine; }
        if (sum == G) break;
        __builtin_amdgcn_s_sleep(1);
        if ((++sp & 255u) == 0u) { if (xb_ld(&bar[XB_TMO])) break; if (sp > XB_SPIN_CAP) { atomicAdd(&bar[XB_TMO], 1u); break; } }
    }
    nloc = mine > 0u ? mine : 1u; nx = cnt > 0u ? cnt : 1u;
}
__device__ __forceinline__ void xcd_barrier(unsigned char* wsb) {
    asm volatile("s_waitcnt vmcnt(0)" ::: "memory");
    __syncthreads();
    if (threadIdx.x == 0) {
        XcdBarrier b; b.bar = (unsigned*)(wsb + WS_BAR); b.x = xb_xcc_id(); b.st = (volatile LAS unsigned*)(LAS unsigned char*)(smem + 128 * 1024);
        unsigned* bar = b.bar;
        __builtin_amdgcn_s_waitcnt(0);
        unsigned nloc = b.st[0], nx = b.st[1];
        if (nloc == 0u) { xcd_barrier_complete(bar, b.x, nloc, nx); b.st[0] = nloc; b.st[1] = nx; }
        const unsigned old = xb_add(&bar[XB_XSUB(b.x)], 1u);
        const unsigned gen = old / nloc;
        if (old + 1u == (gen + 1u) * nloc) {
            __builtin_amdgcn_fence(__ATOMIC_RELEASE, "agent");
            asm volatile("s_waitcnt vmcnt(0)" ::: "memory");
            const unsigned og = xb_add(&bar[XB_TOP], 1u);
            const unsigned tg = og / nx;
            if (og + 1u == (tg + 1u) * nx) xb_add(&bar[XB_TOPGEN], 1u);
            else XB_SPIN(xb_ld(&bar[XB_TOPGEN]) == tg, bar);
            __builtin_amdgcn_fence(__ATOMIC_ACQUIRE, "agent");
            xb_add(&bar[XB_XGEN(b.x)], 1u);
            asm volatile("s_waitcnt vmcnt(0)" ::: "memory");
        } else {
            XB_SPIN(xb_ld(&bar[XB_XGEN(b.x)]) == gen, bar);
            __builtin_amdgcn_fence(__ATOMIC_ACQUIRE, "agent");
            asm volatile("s_waitcnt vmcnt(0)" ::: "memory");
        }
    }
    __syncthreads();
}

template <bool COOP, bool FUSELN>
__global__ void __launch_bounds__(512) fwd_kernel(Params P, int ph_lo, int ph_hi) {
    unsigned char* ws = P.ws;
#ifndef PHMASK
#define PHMASK 0x7ff
#endif
#define RUN_PHASE(k, body) do { if ((PHMASK & (1 << k)) && (COOP || (ph_lo <= k && k < ph_hi))) { body; } if (COOP && k < 10) xcd_barrier(P.ws); } while (0)
    if (COOP) {
        unsigned* bar = (unsigned*)(ws + WS_BAR);
        volatile LAS unsigned* st = (volatile LAS unsigned*)(LAS unsigned char*)(smem + 128 * 1024);
        if (threadIdx.x == 0) { st[0] = 0u; st[1] = 0u; }
        __syncthreads();
        (void)xcd_barrier_post(bar, st);
        if (ph_hi > 1000) cg::this_grid().sync();
        phase0(P);
        xcd_barrier(P.ws);
    } else {
        if (ph_lo == 0) phase0(P);
    }
    RUN_PHASE(1, (gemm_phase<D, EPI_PROJ>(P, (const bf16_t*)(ws + WS_XB), (const bf16_t*)(ws + WS_WIN), L / BM, DIN / BM)));
    if (COOP && FUSELN) {
        ssm_phase<false, true>(P);
        xcd_barrier(P.ws);
        ssm_phase<true, true>(P);
        sconv_phase<true>(P, 0, gridDim.x);
        xcd_barrier(P.ws);
    } else {
        RUN_PHASE(2, ssm_phase<false>(P));
        RUN_PHASE(3, carry_phase(P); sconv_phase(P, 0, gridDim.x));
        RUN_PHASE(4, ssm_phase<true>(P));
    }
    RUN_PHASE(5, (glu_sconv_phase(P)));
    if (COOP && FUSELN) {
        gemm_phase<D, EPI_OUT, true>(P, (const bf16_t*)(ws + WS_YMIX), (const bf16_t*)(ws + WS_WOUT), L / BM, D / BM);
        xcd_barrier(P.ws);
    } else {
        RUN_PHASE(6, (gemm_phase<D, EPI_OUT>(P, (const bf16_t*)(ws + WS_YMIX), (const bf16_t*)(ws + WS_WOUT), L / BM, D / BM)));
        RUN_PHASE(7, ln_phase<true>(P));
    }
    RUN_PHASE(8, ffn_phase(P));
    if (COOP && FUSELN) {
        gemm_phase<DFF, EPI_DOWN, true>(P, (const bf16_t*)(ws + WS_ACT), (const bf16_t*)(ws + WS_WD), L / BM, D / BM);
    } else {
        RUN_PHASE(9, (gemm_phase<DFF, EPI_DOWN>(P, (const bf16_t*)(ws + WS_ACT), (const bf16_t*)(ws + WS_WD), L / BM, D / BM)));
        RUN_PHASE(10, ln_phase<false>(P));
    }
}

constexpr int LDS_BYTES = 128 * 1024 + 64;

extern "C" void kernel_launch(void* const* d_in, const int* in_sizes, int n_in, void* d_out, int out_size, void* d_ws, size_t ws_size, hipStream_t stream) {
    static int grid = 0;
    if (grid == 0) {
        int dev = 0, cus = 0, per_cu = 0;
        hipGetDevice(&dev);
        hipDeviceGetAttribute(&cus, hipDeviceAttributeMultiprocessorCount, dev);
        hipFuncSetAttribute((const void*)fwd_kernel<true, true>, hipFuncAttributeMaxDynamicSharedMemorySize, LDS_BYTES);
        hipFuncSetAttribute((const void*)fwd_kernel<true, false>, hipFuncAttributeMaxDynamicSharedMemorySize, LDS_BYTES);
        hipFuncSetAttribute((const void*)fwd_kernel<false, false>, hipFuncAttributeMaxDynamicSharedMemorySize, LDS_BYTES);
        hipOccupancyMaxActiveBlocksPerMultiprocessor(&per_cu, (const void*)fwd_kernel<true, true>, 512, LDS_BYTES);
        if (per_cu < 1) per_cu = 1;
        grid = cus * per_cu;
        if (n_in != 25 || ws_size < 256 * MiB) fprintf(stderr, "kernel_launch: unexpected n_in %d / ws_size %zu\n", n_in, ws_size);
        (void)hipGetLastError();
    }
    Params p{};
    const float** pp = (const float**)&p;
    for (int i = 0; i < 25; ++i) pp[i] = (const float*)d_in[i];
    p.out = (float*)d_out; p.ws = (unsigned char*)d_ws;
    (void)hipMemsetAsync((unsigned char*)d_ws + WS_BAR, 0, XCD_BAR_WORDS * 4 + 256, stream);
#if N_LAUNCH == 1
    int lo = 0, hi = 11;
    void* args[] = {&p, &lo, &hi};
    const bool fuse = (grid == (L / BM) * (D / BM));
    hipError_t e = hipLaunchCooperativeKernel(fuse ? (const void*)fwd_kernel<true, true> : (const void*)fwd_kernel<true, false>, dim3(grid), dim3(512), args, LDS_BYTES, stream);
    if (e != hipSuccess) fprintf(stderr, "cooperative launch failed: %s (grid %d)\n", hipGetErrorString(e), grid);
#else
    for (int ph = 0; ph < 11; ++ph) hipLaunchKernelGGL(fwd_kernel<false, false>, dim3(grid), dim3(512), LDS_BYTES, stream, p, ph, ph + 1);
#endif
}
```
